# Optimizing an MI355X kernel written in HIP

```python
import math
import jax, jax.numpy as jnp
from jax import lax
import numpy as np

D_MODEL = 1024
BATCH = 16
SEQ = 256
DEPTH = 2
DEC_BATCH = 4
DEC_SEQ = 4096
PAST_LEN = 256

GRID_W = 64
EXPAND = 2
D_INNER = EXPAND * D_MODEL
A_WIDTH = D_INNER // 2
A_HEAD = 64
A_HEADS = A_WIDTH // A_HEAD
DECAY_LORA = 64
ICLR_LORA = 64
B_WIDTH = D_INNER // 2
B_HD = 64
B_HEADS = B_WIDTH // (2 * B_HD)
B_QK = B_HEADS * 2 * B_HD
C_WIDTH = D_INNER
CONV_W = 3
N_EVEN = (DEPTH + 1) // 2
N_ODD = DEPTH // 2
A_SHIFT_SIZES = (A_WIDTH, A_WIDTH, A_WIDTH, DECAY_LORA, DECAY_LORA, ICLR_LORA, ICLR_LORA)
A_SHIFT_COLS = sum(A_SHIFT_SIZES)
EVEN_SIZES = (A_SHIFT_COLS, A_WIDTH, B_QK, B_QK, B_WIDTH, B_WIDTH)
EVEN_IN = sum(EVEN_SIZES)
ODD_IN = 4 * C_WIDTH
Q_BLOCK = 128
ROPE_BASE = 10000.0
NORM_EPS = 1e-6
GN_EPS = 64e-5

kernel_name = 'hybrid_rwkv7_diffattn_shortconv_diffusion_step'


def _split(x, sizes):
    return jnp.split(x, [int(i) for i in np.cumsum(sizes)[:-1]], axis=-1)


def _rms(x, w):
    xf = x.astype(jnp.float32)
    y = xf * lax.rsqrt(jnp.mean(xf * xf, axis=-1, keepdims=True) + NORM_EPS)
    return (y * w.astype(jnp.float32)).astype(x.dtype)


def _ada(cvec, w, b):
    m = jax.nn.silu(cvec) @ w + b
    shift, scale, gate = jnp.split(m, 3, axis=-1)
    return shift[:, None, :], scale[:, None, :], gate[:, None, :]


def _centred_shift(p):
    zero = jnp.zeros_like(p[:, :1])
    prev = jnp.concatenate([zero, p[:, :-1]], axis=1)
    nxt = jnp.concatenate([p[:, 1:], zero], axis=1)
    return 0.5 * (prev + nxt)


def _axial_rope_angles(n_rows):
    row = jnp.repeat(jnp.arange(n_rows, dtype=jnp.float32), GRID_W)
    col = jnp.tile(jnp.arange(GRID_W, dtype=jnp.float32), n_rows)
    half = B_HD // 2
    inv = ROPE_BASE ** (-jnp.arange(0, half, 2, dtype=jnp.float32) / half)
    ang_row = (row[:, None] * inv)[:, None, None, :]
    ang_col = (col[:, None] * inv)[:, None, None, :]
    return ang_row, ang_col


def _rope_chunk(x, ang):
    x1, x2 = jnp.split(x, 2, axis=-1)
    cos, sin = jnp.cos(ang), jnp.sin(ang)
    return jnp.concatenate([x1 * cos - x2 * sin, x2 * cos + x1 * sin], axis=-1)


def _apply_axial_rope(x, ang_row, ang_col):
    xr, xc = jnp.split(x.astype(jnp.float32), 2, axis=-1)
    return jnp.concatenate([_rope_chunk(xr, ang_row), _rope_chunk(xc, ang_col)], axis=-1).astype(x.dtype)


def _rwkv_scan(r, w, k, v, kk, a, s0, reverse):
    def step(S, inp):
        r_t, w_t, k_t, v_t, kk_t, a_t = inp
        s_kk = jnp.einsum('bhvk,bhk->bhv', S, kk_t)
        S = (S * w_t[:, :, None, :] - s_kk[..., None] * (kk_t * a_t)[:, :, None, :]
             + v_t[..., None] * k_t[:, :, None, :])
        return S, jnp.einsum('bhvk,bhk->bhv', S, r_t)
    xs = tuple(jnp.moveaxis(t, 1, 0) for t in (r, w, k, v, kk, a))
    s_fin, o = lax.scan(step, s0, xs, reverse=reverse)
    return jnp.moveaxis(o, 0, 1), s_fin


def _rwkv_branch(pa, ga, s0_f, s0_b, mu, w0, w_up, a0, a_up, k_k, k_a, r_k, lnx_w, lnx_b):
    bsz, t_len, _ = pa.shape
    f32 = jnp.float32
    heads = lambda t: t.reshape(bsz, t_len, A_HEADS, A_HEAD)
    p = pa.astype(f32)
    p = p + mu * (_centred_shift(p) - p)
    r, k, v, wl_f, wl_b, al_f, al_b = _split(p, A_SHIFT_SIZES)
    kk = heads(k * k_k)
    kk = kk / jnp.maximum(jnp.sqrt(jnp.sum(kk * kk, axis=-1, keepdims=True)), 1e-12)
    r_h, v_h = heads(r), heads(v)
    outs, bonuses, states = [], [], []
    for d, (wl, al, s0) in enumerate(((wl_f, al_f, s0_f), (wl_b, al_b, s0_b))):
        wlog = -jax.nn.softplus(-(w0[d] + jnp.tanh(wl) @ w_up[d])) - 0.5
        decay = jnp.exp(-jnp.exp(wlog))
        a = jax.nn.sigmoid(a0[d] + al @ a_up[d])
        k_d = heads(k * (1.0 + (a - 1.0) * k_a))
        o_d, s_d = _rwkv_scan(r_h, heads(decay), k_d, v_h, kk, heads(a), s0.astype(f32), reverse=(d == 1))
        outs.append(o_d)
        bonuses.append(jnp.sum(r_h * k_d * r_k, axis=-1, keepdims=True) * v_h)
        states.append(s_d.astype(pa.dtype))
    o = outs[0] + outs[1]
    mean = jnp.mean(o, axis=-1, keepdims=True)
    var = jnp.mean(jnp.square(o - mean), axis=-1, keepdims=True)
    o = ((o - mean) * lax.rsqrt(var + GN_EPS) * lnx_w.reshape(A_HEADS, A_HEAD)
         + lnx_b.reshape(A_HEADS, A_HEAD))
    y = (o + bonuses[0] + bonuses[1]).reshape(bsz, t_len, A_WIDTH).astype(ga.dtype) * jax.nn.silu(ga)
    return y, states[0], states[1]


def _diff_attend_block(qb, k, v, lam):
    s = jnp.einsum('bqhcd,bkhcd->bhcqk', qb, k) * (B_HD ** -0.5)
    p = jax.nn.softmax(s, axis=-1)
    attn = p[:, :, 0] - lam * p[:, :, 1]
    return jnp.einsum('bhqk,bkhe->bqhe', attn, v)


def _diff_attend(q, k, v, lam):
    bsz, t_len = q.shape[:2]
    nb = t_len // Q_BLOCK
    qb = jnp.moveaxis(q.reshape(bsz, nb, Q_BLOCK, B_HEADS, 2, B_HD), 1, 0)
    o = lax.map(lambda blk: _diff_attend_block(blk, k, v, lam), qb)
    return jnp.moveaxis(o, 0, 1).reshape(bsz, t_len, B_HEADS, 2 * B_HD)


def _diff_branch(pq, pk, pv, gb, q_norm, k_norm, lam_vec, subln_w, lam_init, rope, ctx_k, ctx_v):
    bsz, t_len, _ = pq.shape
    f32 = jnp.float32
    q = _rms(pq.reshape(bsz, t_len, B_HEADS, 2, B_HD), q_norm)
    k = _rms(pk.reshape(bsz, t_len, B_HEADS, 2, B_HD), k_norm)
    v = pv.reshape(bsz, t_len, B_HEADS, 2 * B_HD)
    if rope is None:
        keys, vals = k, v
    else:
        ang_row, ang_col = rope
        q = _apply_axial_rope(q, ang_row, ang_col)
        keys = jnp.concatenate([_apply_axial_rope(k, ang_row, ang_col), ctx_k.astype(k.dtype)], axis=1)
        vals = jnp.concatenate([v, ctx_v.astype(v.dtype)], axis=1)
    lf = lam_vec.astype(f32)
    lam = jnp.exp(jnp.sum(lf[0] * lf[1])) - jnp.exp(jnp.sum(lf[2] * lf[3])) + lam_init
    o = _diff_attend(q.astype(f32), keys.astype(f32), vals.astype(f32), lam)
    o = _rms(o, subln_w) * (1.0 - lam_init)
    y = o.reshape(bsz, t_len, B_WIDTH).astype(pq.dtype) * jax.nn.silu(gb)
    return y, k, v


def _even_mixer(h, rope, s0_f, s0_b, ctx_k, ctx_v, w_in, w_out, rw, dp):
    pa, ga, pq, pk, pv, gb = _split(h @ w_in, EVEN_SIZES)
    ya, s_f, s_b = _rwkv_branch(pa, ga, s0_f, s0_b, *rw)
    yb, k_c, v_c = _diff_branch(pq, pk, pv, gb, *dp, rope, ctx_k, ctx_v)
    return jnp.concatenate([ya, yb], axis=-1) @ w_out, s_f, s_b, k_c, v_c


def _dwconv3(u, w, b):
    pad = (CONV_W - 1) // 2
    out = lax.conv_general_dilated(u, w[:, None, :].astype(u.dtype), window_strides=(1,),
                                   padding=((pad, pad),), dimension_numbers=('NWC', 'WIO', 'NWC'),
                                   feature_group_count=u.shape[-1])
    return out + b


def _odd_mixer(h, w_in, conv_w, conv_b, w_out):
    bg, cg, u, z = jnp.split(h @ w_in, 4, axis=-1)
    y = bg * _dwconv3(cg * u, conv_w, conv_b) * jax.nn.silu(z)
    return y @ w_out


def setup_inputs(seed: int = 0) -> dict:
    key = jax.random.key(seed)
    ks = iter(jax.random.split(key, 40))
    nrm = lambda shape, s=1.0: s * jax.random.normal(next(ks), shape, jnp.float32)
    return {
        'x_prompt': nrm((BATCH, SEQ, D_MODEL)),
        'x_sample': nrm((DEC_BATCH, DEC_SEQ, D_MODEL)),
        'state_rwkv_fwd': nrm((DEC_BATCH, N_EVEN, A_HEADS, A_HEAD, A_HEAD)),
        'state_rwkv_bwd': nrm((DEC_BATCH, N_EVEN, A_HEADS, A_HEAD, A_HEAD)),
        'cache_diff_k': nrm((DEC_BATCH, N_EVEN, PAST_LEN, B_HEADS, 2, B_HD)),
        'cache_diff_v': nrm((DEC_BATCH, N_EVEN, PAST_LEN, B_HEADS, 2 * B_HD)),
        'c': nrm((DEC_BATCH, D_MODEL)),
        'c_ctx': nrm((D_MODEL,)),
        'norm_w': 1.0 + nrm((DEPTH, D_MODEL), 0.1),
        'ada_w': nrm((DEPTH, D_MODEL, 3 * D_MODEL), 0.5 * D_MODEL ** -0.5),
        'ada_b': nrm((DEPTH, 3 * D_MODEL), 0.02),
        'e_w_in': nrm((N_EVEN, D_MODEL, EVEN_IN), D_MODEL ** -0.5),
        'e_w_out': nrm((N_EVEN, A_WIDTH + B_WIDTH, D_MODEL), (A_WIDTH + B_WIDTH) ** -0.5),
        'e_mu': jax.random.uniform(next(ks), (N_EVEN, A_SHIFT_COLS), jnp.float32),
        'e_w0': -2.0 + nrm((N_EVEN, 2, A_WIDTH), 0.5),
        'e_w_up': nrm((N_EVEN, 2, DECAY_LORA, A_WIDTH), 0.1),
        'e_a0': nrm((N_EVEN, 2, A_WIDTH), 0.1),
        'e_a_up': nrm((N_EVEN, 2, ICLR_LORA, A_WIDTH), 0.1),
        'e_k_k': 0.85 + nrm((N_EVEN, A_WIDTH), 0.05),
        'e_k_a': 1.0 + nrm((N_EVEN, A_WIDTH), 0.05),
        'e_r_k': nrm((N_EVEN, A_HEADS, A_HEAD), 0.1),
        'e_lnx_w': 1.0 + nrm((N_EVEN, A_WIDTH), 0.1),
        'e_lnx_b': nrm((N_EVEN, A_WIDTH), 0.02),
        'e_q_norm': 1.0 + nrm((N_EVEN, B_HD), 0.1),
        'e_k_norm': 1.0 + nrm((N_EVEN, B_HD), 0.1),
        'e_lambda': nrm((N_EVEN, 4, B_HD), 0.1),
        'e_subln': 1.0 + nrm((N_EVEN, 2 * B_HD), 0.1),
        'o_w_in': nrm((N_ODD, D_MODEL, ODD_IN), D_MODEL ** -0.5),
        'o_conv_w': nrm((N_ODD, CONV_W, C_WIDTH), CONV_W ** -0.5),
        'o_conv_b': nrm((N_ODD, C_WIDTH), 0.02),
        'o_w_out': nrm((N_ODD, C_WIDTH, D_MODEL), C_WIDTH ** -0.5),
    }


def reference(x_prompt, x_sample, state_rwkv_fwd, state_rwkv_bwd, cache_diff_k, cache_diff_v, c, c_ctx,
              norm_w, ada_w, ada_b,
              e_w_in, e_w_out, e_mu, e_w0, e_w_up, e_a0, e_a_up, e_k_k, e_k_a, e_r_k, e_lnx_w, e_lnx_b,
              e_q_norm, e_k_norm, e_lambda, e_subln,
              o_w_in, o_conv_w, o_conv_b, o_w_out):
    n_rows = x_sample.shape[1] // GRID_W
    rope = _axial_rope_angles(n_rows)
    xp, xs = x_prompt, x_sample
    new_sf, new_sb, new_k, new_v = [], [], [], []
    for layer in range(DEPTH):
        sh_p, sc_p, g_p = _ada(c_ctx[None, :], ada_w[layer], ada_b[layer])
        sh_s, sc_s, g_s = _ada(c, ada_w[layer], ada_b[layer])
        hp = _rms(xp, norm_w[layer]) * (1.0 + sc_p) + sh_p
        hs = _rms(xs, norm_w[layer]) * (1.0 + sc_s) + sh_s
        i = layer // 2
        if layer % 2 == 0:
            lam_init = 0.8 - 0.6 * math.exp(-0.3 * layer)
            rw = (e_mu[i], e_w0[i], e_w_up[i], e_a0[i], e_a_up[i], e_k_k[i], e_k_a[i], e_r_k[i],
                  e_lnx_w[i], e_lnx_b[i])
            dp = (e_q_norm[i], e_k_norm[i], e_lambda[i], e_subln[i], lam_init)
            zeros = jnp.zeros((xp.shape[0], A_HEADS, A_HEAD, A_HEAD), jnp.float32)
            op, s_f, s_b, k_c, v_c = _even_mixer(hp, None, zeros, zeros, None, None,
                                                 e_w_in[i], e_w_out[i], rw, dp)
            os_, _, _, _, _ = _even_mixer(hs, rope, state_rwkv_fwd[:, i], state_rwkv_bwd[:, i],
                                          cache_diff_k[:, i], cache_diff_v[:, i],
                                          e_w_in[i], e_w_out[i], rw, dp)
            new_sf.append(s_f)
            new_sb.append(s_b)
            new_k.append(k_c)
            new_v.append(v_c)
        else:
            op = _odd_mixer(hp, o_w_in[i], o_conv_w[i], o_conv_b[i], o_w_out[i])
            os_ = _odd_mixer(hs, o_w_in[i], o_conv_w[i], o_conv_b[i], o_w_out[i])
        xp = xp + (g_p * op).astype(xp.dtype)
        xs = xs + (g_s * os_).astype(xs.dtype)
    return (xp, xs, jnp.stack(new_sf, axis=1), jnp.stack(new_sb, axis=1),
            jnp.stack(new_k, axis=1), jnp.stack(new_v, axis=1))
```

```cpp
#include <hip/hip_runtime.h>
#include <cstdio>
#include <cstdint>
namespace pg8 {
#define PG8_LAS __attribute__((address_space(3)))
typedef unsigned short bf16_t;
typedef short bf16x8 __attribute__((ext_vector_type(8)));
typedef float f32x4 __attribute__((ext_vector_type(4)));
typedef unsigned u32x4 __attribute__((ext_vector_type(4)));
constexpr int BM = 256, BK = 64, HALF = 128, HTB = HALF * BK * 2  , STAGE_BYTES = 8 * HTB, NXCD = 8, WGM = 8;

__host__ __device__ __forceinline__ int lds_byte(int r, int c) { const int st = (r >> 4) * 2 + (c >> 5), rr = r & 15, cc = c & 31, ob = rr * 64 + cc * 2; return st * 1024 + (ob ^ (((ob >> 9) & 1) << 5)); }
__host__ __device__ __forceinline__ void stage_rc(int b, int& R, int& C) { const int st = b / 1024, sb = b % 1024, swz = sb ^ (((sb >> 9) & 1) << 5); R = (st >> 1) * 16 + swz / 64; C = (st & 1) * 32 + (swz % 64) / 2; }
__host__ __device__ __forceinline__ int perm32(int rho) { const int n = rho >> 4, i = rho & 15; return 8 * (i >> 2) + 4 * n + (i & 3); }

struct Unit { int pm, pn, k0, nt, part, tix; };
struct Gemm { const bf16_t* A; const bf16_t* Bt; int M, N, K, lda; };

struct StaticOrder {
    int nM, nN, nwg, G, c, ntk;
    __host__ __device__ void init(int M, int N, int K, int G_, int c_) { nM = M / BM; nN = N / BM; nwg = nM * nN; G = G_; c = c_; ntk = K / BK; }
    __host__ __device__ bool tile(long L, Unit& u) const {
        if (L >= nwg) return false;
        int wgid = (int)L; { const int q = nwg / NXCD, r = nwg % NXCD, xcd = wgid % NXCD, off = wgid / NXCD; wgid = (xcd < r ? xcd * (q + 1) : r * (q + 1) + (xcd - r) * q) + off; }
        const int nig = WGM * nN, gid = wgid / nig, fm = gid * WGM, gsz = (nM - fm) < WGM ? (nM - fm) : WGM;
        u.pm = fm + ((wgid % nig) % gsz); u.pn = (wgid % nig) / gsz; u.k0 = 0; u.nt = ntk; u.part = -1; u.tix = 0; return true;
    }
    __host__ __device__ bool next(int i, Unit& u) const { return tile((long)i * G + c, u); }
    __device__ __forceinline__ void a_ready(const Unit&) const {}
    __device__ __forceinline__ void done(const Unit&) const {}
};
struct TailSplitOrder {
    StaticOrder s; int split;
    __host__ __device__ void init(int M, int N, int K, int G_, int c_) { s.init(M, N, K, G_, c_); split = (s.nwg > G_ && 4 * (s.nwg - G_) == G_ && (s.ntk % 8) == 0) ? 1 : 0; }
    __host__ __device__ bool next(int i, Unit& u) const {
        if (!split || i == 0) return s.next(i, u);
        if (i > 1) return false;
        int j, t; if (s.G % 32 == 0) { const int x = s.c & 7, r = s.c >> 3; j = r & 3; t = (r >> 2) * 8 + x; } else { j = s.c & 3; t = s.c >> 2; }
        if (!s.tile((long)s.G + t, u)) return false;
        u.nt = s.ntk / 4; u.k0 = j * u.nt; u.part = j; u.tix = t; return true;
    }
    __device__ __forceinline__ void a_ready(const Unit&) const {}
    __device__ __forceinline__ void done(const Unit&) const {}
};


template <class Epi, class Sched, bool ALIGN_EPI = false, bool SP2 = false>
__device__ __forceinline__ void gemm_phase(PG8_LAS unsigned char* lds, const Gemm g, const Sched& S, const Epi& E) {
    const int tid = threadIdx.x, wid = __builtin_amdgcn_readfirstlane(tid >> 6), lane = tid & 63, wr = wid >> 2, wc = wid & 3, fr = lane & 15, fq = lane >> 4;
    const int K = g.K;
    unsigned voffA[2], voffB[2];
#pragma unroll
    for (int i = 0; i < 2; ++i) { int R, C; stage_rc(tid * 16 + i * 8192, R, C); const int Rb = Epi::PERM ? ((R & ~31) + perm32(R & 31)) : R;
        voffA[i] = (unsigned)(R * g.lda + C) * 2u; voffB[i] = (unsigned)(Rb * K + C) * 2u; }
    const size_t kstep = (size_t)(BK * 2);
    const size_t hstep = (size_t)HALF * K * 2;
    const size_t hstepA = (size_t)HALF * g.lda * 2, tstepA = 2 * hstepA;
    const size_t tstep = 2 * hstep;
    const unsigned ldsw = (unsigned)wid * 1024u;
    const int aoff = lds_byte(wr * 64 + fr, fq * 8), boff = lds_byte(wc * 32 + fr, fq * 8);
#define PG8_SA(b, h) (((b) * 2 + (h)) * HTB)
#define PG8_SB(b, h) ((4 + (b) * 2 + (h)) * HTB)
#define PG8_STAGE(bufoff, gbase, voff) do { _Pragma("unroll") for (int _i = 0; _i < 2; ++_i) \
        __builtin_amdgcn_global_load_lds((const unsigned*)((const char*)(gbase) + (voff)[_i]), (PG8_LAS unsigned*)(lds + (bufoff) + ldsw + _i * 8192), 16, 0, 0); } while (0)
#define PG8_LDA(dst, b, h) do { _Pragma("unroll") for (int m = 0; m < 4; ++m) _Pragma("unroll") for (int k = 0; k < 2; ++k) dst[m][k] = *(const PG8_LAS bf16x8*)(lds + PG8_SA(b, h) + aoff + m * 2048 + k * 1024); } while (0)
#define PG8_LDB(dst, b, h) do { _Pragma("unroll") for (int n = 0; n < 2; ++n) _Pragma("unroll") for (int k = 0; k < 2; ++k) dst[n][k] = *(const PG8_LAS bf16x8*)(lds + PG8_SB(b, h) + boff + n * 2048 + k * 1024); } while (0)
#define PG8_MMA(ai, bj, At, Bt) do { __builtin_amdgcn_s_setprio(1); _Pragma("unroll") for (int m = 0; m < 4; ++m) _Pragma("unroll") for (int n = 0; n < 2; ++n) _Pragma("unroll") for (int k = 0; k < 2; ++k) \
        acc[ai][bj][m][n] = __builtin_amdgcn_mfma_f32_16x16x32_bf16(Bt[n][k], At[m][k], acc[ai][bj][m][n], 0, 0, 0); __builtin_amdgcn_s_setprio(0); } while (0)
#define PG8_WAIT_V(n) asm volatile("s_waitcnt vmcnt(" #n ")" ::: "memory")
#define PG8_WAIT_L(n) asm volatile("s_waitcnt lgkmcnt(" #n ")" ::: "memory")
#define PG8_BAR __builtin_amdgcn_s_barrier()
#define PG8_SCHED __builtin_amdgcn_sched_barrier(0)
    Unit cur, nxt; int ui = 0;
    if (!S.next(0, cur)) return;
    f32x4 acc[2][2][4][2];
#pragma unroll
    for (int a = 0; a < 2; ++a)
#pragma unroll
        for (int b = 0; b < 2; ++b)
#pragma unroll
            for (int m = 0; m < 4; ++m)
#pragma unroll
                for (int n = 0; n < 2; ++n) acc[a][b][m][n] = (f32x4){0.f, 0.f, 0.f, 0.f};
    bf16x8 At[4][2], B0[2][2], B1[2][2];
    const char* cA = (const char*)g.A + (size_t)cur.pm * tstepA + (size_t)cur.k0 * kstep; const char* cB = (const char*)g.Bt + (size_t)cur.pn * tstep + (size_t)cur.k0 * kstep;
    S.a_ready(cur);
    if constexpr (SP2) {
        PG8_STAGE(PG8_SB(0, 0), cB, voffB); PG8_STAGE(PG8_SB(0, 1), cB + hstep, voffB); PG8_STAGE(PG8_SA(0, 0), cA, voffA); PG8_STAGE(PG8_SA(0, 1), cA + hstepA, voffA);
        if (wr == 1) PG8_BAR;
        PG8_WAIT_V(2); PG8_BAR;
        PG8_STAGE(PG8_SB(1, 0), cB + kstep, voffB); PG8_STAGE(PG8_SA(1, 0), cA + kstep, voffA); PG8_STAGE(PG8_SB(1, 1), cB + hstep + kstep, voffB);
        PG8_WAIT_V(6); PG8_BAR;
    } else {
        PG8_STAGE(PG8_SB(0, 0), cB, voffB); PG8_STAGE(PG8_SA(0, 0), cA, voffA); PG8_STAGE(PG8_SB(0, 1), cB + hstep, voffB); PG8_STAGE(PG8_SA(0, 1), cA + hstepA, voffA);
        if (wr == 1) PG8_BAR;
        PG8_WAIT_V(4); PG8_BAR;
        PG8_STAGE(PG8_SB(1, 0), cB + kstep, voffB); PG8_STAGE(PG8_SA(1, 0), cA + kstep, voffA); PG8_STAGE(PG8_SB(1, 1), cB + hstep + kstep, voffB);
        PG8_WAIT_V(6); PG8_BAR;
    }
    for (;;) {
        const bool has_next = S.next(ui + 1, nxt);
        const char* nA = has_next ? (const char*)g.A + (size_t)nxt.pm * tstepA + (size_t)nxt.k0 * kstep : cA; const char* nB = has_next ? (const char*)g.Bt + (size_t)nxt.pn * tstep + (size_t)nxt.k0 * kstep : cB;
        const int nt = cur.nt;
        for (int t = 0; t < nt; t += 2) {
            const bool last = (t == nt - 2);
            const char* a1 = cA + (size_t)(t + 1) * kstep;
            const char* a2 = last ? nA : cA + (size_t)(t + 2) * kstep; const char* b2 = last ? nB : cB + (size_t)(t + 2) * kstep;
            const char* a3 = a2 + kstep; const char* b3 = b2 + kstep;
            if (last && has_next) S.a_ready(nxt);
            if constexpr (SP2) {
            PG8_LDB(B0, 0, 0); PG8_LDB(B1, 0, 1); PG8_SCHED; PG8_LDA(At, 0, 0); PG8_STAGE(PG8_SA(1, 1), a1 + hstepA, voffA);
            PG8_WAIT_V(8); PG8_WAIT_L(0); PG8_BAR; PG8_MMA(0, 0, At, B0); PG8_MMA(0, 1, At, B1); PG8_BAR; PG8_SCHED;
            PG8_LDA(At, 0, 1); PG8_STAGE(PG8_SB(0, 0), b2, voffB); PG8_STAGE(PG8_SB(0, 1), b2 + hstep, voffB); PG8_STAGE(PG8_SA(0, 0), a2, voffA);
            PG8_WAIT_V(8); PG8_WAIT_L(0); PG8_BAR; PG8_MMA(1, 0, At, B0); PG8_MMA(1, 1, At, B1); PG8_BAR; PG8_SCHED;
            PG8_LDB(B0, 1, 0); PG8_LDB(B1, 1, 1); PG8_SCHED; PG8_LDA(At, 1, 0); PG8_STAGE(PG8_SA(0, 1), a2 + hstepA, voffA);
            PG8_WAIT_V(8); PG8_WAIT_L(0); PG8_BAR; PG8_MMA(0, 0, At, B0); PG8_MMA(0, 1, At, B1); PG8_BAR; PG8_SCHED;
            PG8_LDA(At, 1, 1); PG8_STAGE(PG8_SB(1, 0), b3, voffB); PG8_STAGE(PG8_SB(1, 1), b3 + hstep, voffB); PG8_STAGE(PG8_SA(1, 0), a3, voffA);
            PG8_WAIT_V(8); PG8_WAIT_L(0); PG8_BAR; PG8_MMA(1, 0, At, B0); PG8_MMA(1, 1, At, B1); PG8_BAR; PG8_SCHED;
            } else {
            PG8_LDB(B0, 0, 0); PG8_SCHED; PG8_LDA(At, 0, 0); PG8_STAGE(PG8_SA(1, 1), a1 + hstepA, voffA);
            PG8_WAIT_L(8); PG8_BAR; PG8_WAIT_L(0); PG8_MMA(0, 0, At, B0); PG8_BAR; PG8_SCHED;
            PG8_LDB(B1, 0, 1); PG8_STAGE(PG8_SB(0, 0), b2, voffB);
            PG8_BAR; PG8_WAIT_L(0); PG8_MMA(0, 1, At, B1); PG8_BAR;
            PG8_LDA(At, 0, 1); PG8_STAGE(PG8_SA(0, 0), a2, voffA);
            PG8_BAR; PG8_WAIT_L(0); PG8_MMA(1, 0, At, B0); PG8_BAR; PG8_SCHED;
            PG8_STAGE(PG8_SB(0, 1), b2 + hstep, voffB);
            PG8_WAIT_V(6); PG8_BAR; PG8_MMA(1, 1, At, B1); PG8_BAR;
            PG8_LDB(B0, 1, 0); PG8_SCHED; PG8_LDA(At, 1, 0); PG8_STAGE(PG8_SA(0, 1), a2 + hstepA, voffA);
            PG8_WAIT_L(8); PG8_BAR; PG8_WAIT_L(0); PG8_MMA(0, 0, At, B0); PG8_BAR; PG8_SCHED;
            PG8_LDB(B1, 1, 1); PG8_STAGE(PG8_SB(1, 0), b3, voffB);
            PG8_BAR; PG8_WAIT_L(0); PG8_MMA(0, 1, At, B1); PG8_BAR;
            PG8_LDA(At, 1, 1); PG8_STAGE(PG8_SA(1, 0), a3, voffA);
            PG8_BAR; PG8_WAIT_L(0); PG8_MMA(1, 0, At, B0); PG8_BAR; PG8_SCHED;
            PG8_STAGE(PG8_SB(1, 1), b3 + hstep, voffB);
            PG8_WAIT_V(6); PG8_BAR; PG8_MMA(1, 1, At, B1); PG8_BAR;
            }
        }
        if constexpr (ALIGN_EPI) { if (wr == 0) PG8_BAR; }
        if constexpr (!Epi::AFTER_DRAIN) { E(acc, cur, wr, wc, fr, fq); S.done(cur); }
        if (!has_next) break;
#pragma unroll
        for (int a = 0; a < 2; ++a)
#pragma unroll
            for (int b = 0; b < 2; ++b)
#pragma unroll
                for (int m = 0; m < 4; ++m)
#pragma unroll
                    for (int n = 0; n < 2; ++n) acc[a][b][m][n] = (f32x4){0.f, 0.f, 0.f, 0.f};
        cur = nxt; cA = nA; cB = nB; ++ui;
        if constexpr (ALIGN_EPI) { if (wr == 1) PG8_BAR; }
    }
    PG8_WAIT_V(0);
    if constexpr (!ALIGN_EPI) { if (wr == 0) PG8_BAR; }
    PG8_BAR;
    if constexpr (Epi::AFTER_DRAIN) { E.fused(acc, cur, wr, wc, fr, fq, lds, wid, lane); S.done(cur); }
#undef PG8_SA
#undef PG8_SB
#undef PG8_STAGE
#undef PG8_LDA
#undef PG8_LDB
#undef PG8_MMA
#undef PG8_WAIT_V
#undef PG8_WAIT_L
#undef PG8_BAR
#undef PG8_SCHED
}
}
#define GAS __attribute__((address_space(1)))
#define LAS __attribute__((address_space(3)))
typedef unsigned short bf16;
typedef unsigned v4u __attribute__((ext_vector_type(4)));
typedef unsigned v2u __attribute__((ext_vector_type(2)));
typedef float f32x4 __attribute__((ext_vector_type(4)));
typedef float f32x16 __attribute__((ext_vector_type(16)));
typedef short bf16x8 __attribute__((ext_vector_type(8)));
typedef short s16x4 __attribute__((ext_vector_type(4)));
typedef _Float16 h8 __attribute__((ext_vector_type(8)));

constexpr int NWAVES = 8, NTHR = 512;
constexpr int D = 1024, NTP = 4096, NTS = 16384, NT = 20480;
constexpr int TP = 256, TS = 4096, TKS = 4352;
constexpr size_t MiB = 1u << 20;
constexpr size_t WS_CTL = 0, CTL_ZERO_BYTES = 65536;
constexpr int CW_SPLIT = 8192;
constexpr size_t WS_ADA = 65536;
constexpr size_t WS_ROPE = 196608;
constexpr size_t WS_KMAX = 204800;
constexpr size_t WS_WUPT = 262144;
constexpr size_t WS_BN = 786432;
constexpr size_t WS_WOUT1 = 4 * MiB;
constexpr size_t WS_WIN = 8 * MiB;
constexpr size_t WS_WOUT0 = 25 * MiB;
constexpr size_t WS_H = 29 * MiB;
constexpr size_t WS_YAB = 69 * MiB;
constexpr size_t WS_X = 149 * MiB;
constexpr size_t WS_CSB = WS_X + 64 * MiB;
constexpr size_t X_PAR = WS_X, X_PAK = WS_X + 40 * MiB, X_PAL = WS_X + 80 * MiB, X_OFP = WS_X + 90 * MiB, X_SMID = WS_X + 98 * MiB;
constexpr size_t X_Q = WS_X, X_KP = WS_X + 40 * MiB, X_KS = WS_X + 48 * MiB;
constexpr size_t WS_PG = WS_YAB;
static_assert(WS_BN + (size_t)NT * 32 * 4 <= WS_WOUT1 && WS_WIN + (size_t)8448 * 1024 * 2 <= WS_WOUT0 && X_OFP + 8 * MiB <= 256 * MiB && X_KS + 34 * MiB <= 256 * MiB && WS_PG + 160 * MiB <= 256 * MiB, "ws map");
constexpr size_t O_Y = 0, O_SF = 80 * MiB, O_SB = 84 * MiB, O_NK = 88 * MiB, O_NV = 104 * MiB;
constexpr size_t O_PAV = 0, O_OB = 40 * MiB, O_OFS = 88 * MiB;
constexpr size_t O_VP = 0, O_VS = 8 * MiB;
constexpr int LDS_BYTES = 147456, LDS_MISC = 147200;

__device__ __forceinline__ unsigned f2bf(float f) { unsigned u = __builtin_bit_cast(unsigned, f); return (u + 0x7fffu + ((u >> 16) & 1u)) >> 16; }
__device__ __forceinline__ unsigned pk2(float lo, float hi) { return f2bf(lo) | (f2bf(hi) << 16); }
__device__ __forceinline__ float bf2f(unsigned h) { return __builtin_bit_cast(float, h << 16); }
__device__ __forceinline__ float bflo(unsigned w) { return __builtin_bit_cast(float, w << 16); }
__device__ __forceinline__ float bfhi(unsigned w) { return __builtin_bit_cast(float, w & 0xffff0000u); }
__device__ __forceinline__ float frcp(float x) { return __builtin_amdgcn_rcpf(x); }
__device__ __forceinline__ float siluf(float x) { return x * frcp(1.f + __expf(-x)); }
__device__ __forceinline__ float sigmf(float x) { return frcp(1.f + __expf(-x)); }
__device__ __forceinline__ float wave_sum(float v) {
#pragma unroll
    for (int o = 1; o < 64; o <<= 1) v += __shfl_xor(v, o);
    return v;
}
__device__ __forceinline__ float wave_max(float v) {
#pragma unroll
    for (int o = 1; o < 64; o <<= 1) v = fmaxf(v, __shfl_xor(v, o));
    return v;
}
template <int CTRL> __device__ __forceinline__ float dppf(float x) { return __builtin_bit_cast(float, __builtin_amdgcn_update_dpp(0, __builtin_bit_cast(int, x), CTRL, 0xf, 0xf, true)); }
__device__ __forceinline__ float sum8(float x) { x += dppf<0xB1>(x); x += dppf<0x4E>(x); x += dppf<0x141>(x); return x; }
__device__ __forceinline__ float sum16(float x) { x = sum8(x); x += dppf<0x140>(x); return x; }

__device__ __forceinline__ void glds16(const void* gsrc, unsigned lds_dst) { unsigned keep;
    asm volatile("s_mov_b32 %0, m0\n\ts_mov_b32 m0, %2\n\ts_nop 0\n\tglobal_load_lds_dwordx4 %1, off\n\ts_mov_b32 m0, %0" : "=&s"(keep) : "v"(gsrc), "s"(lds_dst) : "memory"); }

struct Params {
    const float* in[31];
    float* out;
    unsigned char* ws;
    int ph_lo, ph_hi;
};
enum { I_XP = 0, I_XS, I_SF, I_SB, I_CK, I_CV, I_C, I_CCTX, I_NW, I_ADAW, I_ADAB, I_EWIN, I_EWOUT, I_MU, I_W0, I_WUP, I_A0, I_AUP, I_KK, I_KA, I_RK, I_LNW, I_LNB,
       I_QN, I_KN, I_LAM, I_SUBLN, I_OWIN, I_CONVW, I_CONVB, I_OWOUT };
#define XB_TMO      128
#define XB_XCNT(j)  (256  + 64 * (j))
#define XB_XSUB(j)  (1280 + 64 * (j))
#define XB_XGEN(j)  (2304 + 64 * (j))
#define XB_TOP      3328
#define XB_TOPGEN   3392
#define XCD_BAR_WORDS 3456
#define XB_SPIN_CAP (1u << 18)

__device__ __forceinline__ unsigned xb_ld(unsigned* p)              { return __hip_atomic_load(p, __ATOMIC_RELAXED, __HIP_MEMORY_SCOPE_AGENT); }
__device__ __forceinline__ unsigned xb_add(unsigned* p, unsigned v) { return __hip_atomic_fetch_add(p, v, __ATOMIC_RELAXED, __HIP_MEMORY_SCOPE_AGENT); }
__device__ __forceinline__ unsigned xb_xcc_id() { return (unsigned)__builtin_amdgcn_s_getreg((3 << 11) | 20) & 0xFu; }
#define XB_SPIN(cond, bar) do { unsigned _sp = 0; while (cond) { __builtin_amdgcn_s_sleep(1); \
    if ((++_sp & 255u) == 0u) { if (xb_ld(&(bar)[XB_TMO])) break; if (_sp > XB_SPIN_CAP) { atomicAdd(&(bar)[XB_TMO], 1u); break; } } } } while (0)

struct XcdBarrier {
    unsigned* bar; unsigned x;
    volatile LAS unsigned* st;
};

__device__ __forceinline__ XcdBarrier xcd_barrier_post(unsigned* bar, volatile LAS unsigned* st) {
    XcdBarrier b; b.bar = bar; b.x = xb_xcc_id(); b.st = st;
    if (threadIdx.x == 0) (void)xb_add(&bar[XB_XCNT(b.x)], 1u);
    return b;
}
__device__ __forceinline__ void xcd_barrier_complete(unsigned* bar, unsigned x, unsigned& nloc, unsigned& nx) {
    const unsigned G = gridDim.x * gridDim.y * gridDim.z;
    unsigned sum, cnt, mine, sp = 0u;
    for (;;) {
        sum = 0u; cnt = 0u; mine = 0u;
#pragma unroll
        for (unsigned j = 0; j < 16; ++j) { const unsigned c = xb_ld(&bar[XB_XCNT(j)]); sum += c; cnt += (c > 0u) ? 1u : 0u; mine = (j == x) ? c : mine; }
        if (sum == G) break;
        __builtin_amdgcn_s_sleep(1);
        if ((++sp & 255u) == 0u) { if (xb_ld(&bar[XB_TMO])) break; if (sp > XB_SPIN_CAP) { atomicAdd(&bar[XB_TMO], 1u); break; } }
    }
    nloc = mine > 0u ? mine : 1u; nx = cnt > 0u ? cnt : 1u;
}

__device__ __forceinline__ void xcd_barrier(const XcdBarrier& b) {
    asm volatile("s_waitcnt vmcnt(0)" ::: "memory");
    __syncthreads();
    if (threadIdx.x == 0) {
        unsigned* bar = b.bar;
        __builtin_amdgcn_s_waitcnt(0);
        unsigned nloc = b.st[0], nx = b.st[1];
        if (nloc == 0u) { xcd_barrier_complete(bar, b.x, nloc, nx); b.st[0] = nloc; b.st[1] = nx; }
        const unsigned old = xb_add(&bar[XB_XSUB(b.x)], 1u);
        const unsigned gen = old / nloc;
        if (old + 1u == (gen + 1u) * nloc) {
            __builtin_amdgcn_fence(__ATOMIC_RELEASE, "agent");
            asm volatile("s_waitcnt vmcnt(0)" ::: "memory");
            const unsigned og = xb_add(&bar[XB_TOP], 1u);
            const unsigned tg = og / nx;
            if (og + 1u == (tg + 1u) * nx) xb_add(&bar[XB_TOPGEN], 1u);
            else XB_SPIN(xb_ld(&bar[XB_TOPGEN]) == tg, bar);
            __builtin_amdgcn_fence(__ATOMIC_ACQUIRE, "agent");
            xb_add(&bar[XB_XGEN(b.x)], 1u);
            asm volatile("s_waitcnt vmcnt(0)" ::: "memory");
        } else {
            XB_SPIN(xb_ld(&bar[XB_XGEN(b.x)]) == gen, bar);
            __builtin_amdgcn_fence(__ATOMIC_ACQUIRE, "agent");
            asm volatile("s_waitcnt vmcnt(0)" ::: "memory");
        }
    }
    __syncthreads();
}

__device__ __forceinline__ int perm32d(int rho) { const int n = rho >> 4, i = rho & 15; return 8 * (i >> 2) + 4 * n + (i & 3); }
template <int MAP> __device__ __forceinline__ int srccol(int np) {
    if (MAP == 0) return np;
    if (MAP == 1) {
        if (np < 4352) return (np & ~31) + perm32d(np & 31);
        const int m = np - 4352, tile = m >> 8, rho = m & 255;
        if (tile < 8) { const int bj = rho >> 7, wc = (rho >> 5) & 3, r32 = rho & 31; return 4352 + tile * 256 + 64 * wc + 32 * bj + r32; }
        return 4352 + (m & ~31) + perm32d(m & 31);
    }
    { const int T = np >> 8, rho = np & 255, bj = rho >> 7, wc = (rho >> 5) & 3, n = (rho >> 4) & 1, i = rho & 15; return (2 * bj + n) * 2048 + 64 * T + 16 * wc + i; }
}
template <int MAP> __device__ __forceinline__ void conv_tile(const float* src, int K, int N, bf16* dst, int tile, LAS float* scr) {
    const int tid = threadIdx.x, nkt = K / 64, nt = tile / nkt, kt = tile % nkt, n0 = nt * 64, k0 = kt * 64;
    { const int nn = tid & 63, kq = tid >> 6; const int sc = srccol<MAP>(n0 + nn);
#pragma unroll
      for (int i = 0; i < 8; ++i) { const int kk = kq + 8 * i; scr[kk * 65 + nn] = src[(size_t)(k0 + kk) * N + sc]; } }
    __syncthreads();
    { const int nn = tid >> 3, kc = tid & 7; const LAS float* s = scr + (8 * kc) * 65 + nn;
      v4u o; o.x = pk2(s[0], s[65]); o.y = pk2(s[2 * 65], s[3 * 65]); o.z = pk2(s[4 * 65], s[5 * 65]); o.w = pk2(s[6 * 65], s[7 * 65]);
      *(v4u*)(dst + (size_t)(n0 + nn) * K + k0 + 8 * kc) = o; }
    __syncthreads();
}
__device__ __forceinline__ void ada_item(const Params& p, int item, const LAS float* sc, LAS float* red) {
    const int tid = threadIdx.x, L = item / 96, col0 = (item % 96) * 32, cl = tid & 31, kg = tid >> 5;
    const float* w = p.in[I_ADAW] + ((size_t)L * 1024 + kg * 64) * 3072 + col0 + cl;
    float a0 = 0.f, a1 = 0.f, a2 = 0.f, a3 = 0.f, a4 = 0.f;
#pragma unroll 8
    for (int kk = 0; kk < 64; ++kk) { const float wv = w[(size_t)kk * 3072]; const int k = kg * 64 + kk;
        a0 += sc[k] * wv; a1 += sc[1024 + k] * wv; a2 += sc[2048 + k] * wv; a3 += sc[3072 + k] * wv; a4 += sc[4096 + k] * wv; }
    red[(kg * 5 + 0) * 32 + cl] = a0; red[(kg * 5 + 1) * 32 + cl] = a1; red[(kg * 5 + 2) * 32 + cl] = a2; red[(kg * 5 + 3) * 32 + cl] = a3; red[(kg * 5 + 4) * 32 + cl] = a4;
    __syncthreads();
    if (tid < 160) { const int v = tid >> 5; float s = p.in[I_ADAB][L * 3072 + col0 + cl];
#pragma unroll
        for (int g = 0; g < 16; ++g) s += red[(g * 5 + v) * 32 + cl];
        ((float*)(p.ws + WS_ADA))[(L * 5 + v) * 3072 + col0 + cl] = s; }
    __syncthreads();
}
__device__ __forceinline__ void p0_prologue(const Params& p, LAS unsigned char* lds, int vcu, int G) {
    const int tid = threadIdx.x, lane = tid & 63, wid = tid >> 6;
    LAS float* sc = (LAS float*)lds;
    LAS float* red = (LAS float*)(lds + 20480);
    LAS float* scr = (LAS float*)(lds + 32768);
    constexpr int N_ADA = 192, N_UP = 64, N_ROPE = 1, N_KMAX = 8;
    constexpr int NITEMS = N_ADA + N_UP + N_ROPE + N_KMAX;
    if (vcu < N_ADA) {
        for (int i = tid; i < 5 * 1024; i += NTHR) { const int v = i >> 10, k = i & 1023; const float x = (v == 0) ? p.in[I_CCTX][k] : p.in[I_C][(v - 1) * 1024 + k]; sc[i] = siluf(x); }
        __syncthreads();
    }
    for (int it = vcu; it < NITEMS; it += G) {
        int r = it;
        if (r < N_ADA) { ada_item(p, r, sc, red); continue; } r -= N_ADA;
        if (r < N_UP) { const int md = r >> 4, tl = r & 15;
            const float* src = ((md >> 1) ? p.in[I_AUP] : p.in[I_WUP]) + (size_t)(md & 1) * 64 * 1024;
            conv_tile<0>(src, 64, 1024, (bf16*)(p.ws + WS_WUPT) + (size_t)md * 65536, tl, scr); continue; } r -= N_UP;
        if (r < N_ROPE) { float* rt = (float*)(p.ws + WS_ROPE);
            for (int i = tid; i < 1024; i += NTHR) { const int pos = i >> 4, f = i & 15; const float inv = powf(10000.f, -(float)f / 16.f); const float ang = (float)pos * inv; rt[pos * 32 + f] = cosf(ang); rt[pos * 32 + 16 + f] = sinf(ang); }
            continue; } r -= N_ROPE;
        { const int gi = r * 8 + wid, b = gi >> 4, hc = gi & 15;
          float mx = 0.f;
          for (int q = 0; q < 4; ++q) { const int t = lane + 64 * q; const f32x4* kp = (const f32x4*)(p.in[I_CK] + ((size_t)(b * 256 + t) * 16 + hc) * 64); float ss = 0.f;
#pragma unroll
              for (int j = 0; j < 16; ++j) { const f32x4 v = kp[j]; ss += v.x * v.x + v.y * v.y + v.z * v.z + v.w * v.w; }
              mx = fmaxf(mx, ss); }
          mx = wave_max(mx);
          if (lane == 0) ((float*)(p.ws + WS_KMAX))[gi] = mx; }
    }
}
__device__ __forceinline__ void weight_copies(const Params& p, LAS unsigned char* lds, int vcu, int G) {
    LAS float* scr = (LAS float*)(lds + 32768);
    constexpr int N_EIN = 132 * 16, N_EOUT = 16 * 32, N_OOUT = 16 * 32;
    for (int it = vcu; it < N_EIN + N_EOUT + N_OOUT; it += G) {
        int r = it;
        if (r < N_EIN) { conv_tile<1>(p.in[I_EWIN], 1024, 8448, (bf16*)(p.ws + WS_WIN), r, scr); continue; } r -= N_EIN;
        if (r < N_EOUT) { conv_tile<0>(p.in[I_EWOUT], 2048, 1024, (bf16*)(p.ws + WS_WOUT0), r, scr); continue; } r -= N_EOUT;
        conv_tile<0>(p.in[I_OWOUT], 2048, 1024, (bf16*)(p.ws + WS_WOUT1), r, scr);
    }
}
__device__ __forceinline__ void h_phase(const Params& p, int L, int vcu, int G) {
    const int lane = threadIdx.x & 63, wid = threadIdx.x >> 6, gw = vcu * NWAVES + wid, NGW = G * NWAVES;
    const float* nw = p.in[I_NW] + L * 1024;
    bf16* H = (bf16*)(p.ws + WS_H);
    const int per = (NT + NGW - 1) / NGW, mlo = gw * per, mhi = (mlo + per < NT) ? mlo + per : NT;
    f32x4 fa[4], fb[4]; int cur = -1;
    for (int m = mlo; m < mhi; ++m) {
        const int vec = (m < NTP) ? 0 : 1 + ((m - NTP) >> 12);
        if (vec != cur) { cur = vec; const float* ada = (const float*)(p.ws + WS_ADA) + (size_t)(L * 5 + vec) * 3072;
#pragma unroll
            for (int j = 0; j < 4; ++j) { const int c = 4 * lane + 256 * j; fa[j] = *(const f32x4*)(nw + c) * (*(const f32x4*)(ada + 1024 + c) + 1.f); fb[j] = *(const f32x4*)(ada + c); } }
        const float* xrow = (L == 0) ? ((m < NTP) ? p.in[I_XP] + (size_t)m * 1024 : p.in[I_XS] + (size_t)(m - NTP) * 1024) : p.out + (size_t)m * 1024;
        f32x4 v[4]; float ss = 0.f;
#pragma unroll
        for (int j = 0; j < 4; ++j) { v[j] = *(const f32x4*)(xrow + 4 * lane + 256 * j); ss += v[j].x * v[j].x + v[j].y * v[j].y + v[j].z * v[j].z + v[j].w * v[j].w; }
        const float rstd = rsqrtf(wave_sum(ss) * (1.f / 1024.f) + 1e-6f);
#pragma unroll
        for (int j = 0; j < 4; ++j) { const int c = 4 * lane + 256 * j;
            const f32x4 h = v[j] * rstd * fa[j] + fb[j];
            v2u o; o.x = pk2(h.x, h.y); o.y = pk2(h.z, h.w);
            *(v2u*)(H + (size_t)m * 1024 + c) = o; }
    }
}
__device__ __forceinline__ f32x4 silu4(f32x4 v) { return (f32x4){siluf(v.x), siluf(v.y), siluf(v.z), siluf(v.w)}; }
__device__ __forceinline__ size_t kvrow(int m) { return (m < NTP) ? (size_t)m : (size_t)NTP + (size_t)((m - NTP) >> 12) * TKS + ((m - NTP) & 4095); }

struct Epi1a {
    static constexpr bool PERM = false, AFTER_DRAIN = false;
    unsigned char *ws, *ob;
    __device__ __forceinline__ void operator()(const pg8::f32x4 (&acc)[2][2][4][2], const pg8::Unit& u, int wr_, int wc_, int fr_, int fq_) const {
        int fr = fr_, fq = fq_, wr = wr_, wc = wc_; asm volatile("" : "+v"(fr), "+v"(fq), "+v"(wr), "+v"(wc));
        const int pn = u.pn; unsigned char* base; unsigned boff; int pitch, colt; bool act = false;
        if (pn < 4) { base = ws; boff = (unsigned)X_PAR; pitch = 1024; colt = pn * 256; }
        else if (pn < 8) { base = ws; boff = (unsigned)X_PAK; pitch = 1024; colt = (pn - 4) * 256; }
        else if (pn < 12) { base = ob; boff = (unsigned)O_PAV; pitch = 1024; colt = (pn - 8) * 256; }
        else if (pn == 12) { base = ws; boff = (unsigned)X_PAL; pitch = 256; colt = 0; }
        else { base = ws; boff = (unsigned)WS_YAB; pitch = 2048; colt = (pn - 13) * 256; act = true; }
        const int row0 = u.pm * 256 + wr * 64 + fr, col0 = colt + wc * 32 + 8 * fq;
#pragma unroll
        for (int ai = 0; ai < 2; ++ai)
#pragma unroll
            for (int m = 0; m < 4; ++m) { const unsigned off = boff + ((unsigned)(row0 + ai * 128 + m * 16) * (unsigned)pitch + (unsigned)col0) * 2u;
#pragma unroll
                for (int bj = 0; bj < 2; ++bj) { f32x4 v0 = acc[ai][bj][m][0], v1 = acc[ai][bj][m][1];
                    if (act) { v0 = silu4(v0); v1 = silu4(v1); }
                    v4u w; w.x = pk2(v0[0], v0[1]); w.y = pk2(v0[2], v0[3]); w.z = pk2(v1[0], v1[1]); w.w = pk2(v1[2], v1[3]);
                    *(v4u*)(base + off + bj * 256) = w; } }
    }
};

constexpr float C2 = 0.125f * 1.4426950408889634f;
struct Epi1b {
    static constexpr bool PERM = false, AFTER_DRAIN = false;
    bf16 *q, *kbuf, *vbuf, *yab; float *nk, *nv; const LAS float* tab;
    __device__ __forceinline__ void operator()(const pg8::f32x4 (&acc)[2][2][4][2], const pg8::Unit& u, int wr_, int wc_, int fr_, int fq_) const {
        int fr = fr_, fq = fq_, wr = wr_, wc = wc_; asm volatile("" : "+v"(fr), "+v"(fq), "+v"(wr), "+v"(wc));
        const int pn = u.pn; const int row0 = u.pm * 256 + wr * 64 + fr; const bool prompt = (u.pm < 16);
        if (pn < 8) {
            const bool isq = pn < 4; const int colt = (pn & 3) * 256 + 64 * wc;
            const LAS float* nwp = tab + (isq ? 2048 : 2112);
#pragma unroll
            for (int ai = 0; ai < 2; ++ai)
#pragma unroll
                for (int m = 0; m < 4; ++m) { const int row = row0 + ai * 128 + m * 16;
                    f32x4 x[2][2]; float ss = 0.f;
#pragma unroll
                    for (int bj = 0; bj < 2; ++bj)
#pragma unroll
                        for (int n = 0; n < 2; ++n) { x[bj][n] = acc[ai][bj][m][n]; ss += x[bj][n][0] * x[bj][n][0] + x[bj][n][1] * x[bj][n][1] + x[bj][n][2] * x[bj][n][2] + x[bj][n][3] * x[bj][n][3]; }
                    ss += __shfl_xor(ss, 16); ss += __shfl_xor(ss, 32);
                    const float rstd = rsqrtf(ss * (1.f / 64.f) + 1e-6f);
#pragma unroll
                    for (int bj = 0; bj < 2; ++bj)
#pragma unroll
                        for (int n = 0; n < 2; ++n) x[bj][n] = x[bj][n] * rstd * *(const LAS f32x4*)(nwp + 32 * bj + 16 * n + 4 * fq);
                    if (!isq && prompt) {
                        float* o = nk + (size_t)row * 1024 + colt + 4 * fq;
#pragma unroll
                        for (int bj = 0; bj < 2; ++bj)
#pragma unroll
                            for (int n = 0; n < 2; ++n) *(f32x4*)(o + 32 * bj + 16 * n) = x[bj][n];
                    }
                    if (!prompt) {
                        const int t = (row - NTP) & 4095;
#pragma unroll
                        for (int bj = 0; bj < 2; ++bj) { const int pos = bj ? (t & 63) : (t >> 6);
                            const LAS float* rp = tab + pos * 32 + 4 * fq; const f32x4 cs = *(const LAS f32x4*)rp, sn = *(const LAS f32x4*)(rp + 16);
                            const f32x4 a = x[bj][0], b = x[bj][1];
                            x[bj][0] = a * cs - b * sn; x[bj][1] = b * cs + a * sn; }
                    }
                    bf16* o = isq ? (q + (size_t)row * 1024) : (kbuf + kvrow(row) * 1024);
                    o += colt + ((fq & 1) ? 12 + 4 * fq : 4 * fq); const float sc = isq ? C2 : 1.f;
#pragma unroll
                    for (int bj = 0; bj < 2; ++bj) { const f32x4 y0 = x[bj][0] * sc, y1 = x[bj][1] * sc; v4u w;
                        typedef unsigned u2_t __attribute__((ext_vector_type(2)));
                        const u2_t s0 = __builtin_amdgcn_permlane16_swap(pk2(y0[0], y0[1]), pk2(y1[0], y1[1]), false, false), s1 = __builtin_amdgcn_permlane16_swap(pk2(y0[2], y0[3]), pk2(y1[2], y1[3]), false, false);
                        w.x = s0[0]; w.y = s1[0]; w.z = s0[1]; w.w = s1[1];
                        *(v4u*)(o + 32 * bj) = w; }
                }
        } else {
            const bool isv = pn < 12; const int colt = (pn & 3) * 256, col0 = colt + wc * 32 + 8 * fq;
#pragma unroll
            for (int ai = 0; ai < 2; ++ai)
#pragma unroll
                for (int m = 0; m < 4; ++m) { const int row = row0 + ai * 128 + m * 16;
                    bf16* rowp = isv ? (vbuf + kvrow(row) * 1024 + col0) : (yab + (size_t)row * 2048 + 1024 + col0);
#pragma unroll
                    for (int bj = 0; bj < 2; ++bj) { f32x4 v0 = acc[ai][bj][m][0], v1 = acc[ai][bj][m][1];
                        if (isv && prompt) { float* o = nv + (size_t)row * 1024 + col0 + bj * 128; *(f32x4*)o = v0; *(f32x4*)(o + 4) = v1; }
                        if (!isv) { v0 = silu4(v0); v1 = silu4(v1); }
                        v4u w; w.x = pk2(v0[0], v0[1]); w.y = pk2(v0[2], v0[3]); w.z = pk2(v1[0], v1[1]); w.w = pk2(v1[2], v1[3]);
                        *(v4u*)(rowp + bj * 128) = w; } }
        }
    }
};

typedef _Float16 h2_t __attribute__((ext_vector_type(2)));
__device__ __forceinline__ unsigned ph2x(float a, float b) { h2_t h; h.x = (_Float16)a; h.y = (_Float16)b; return __builtin_bit_cast(unsigned, h); }
__device__ __forceinline__ float hlo(unsigned u) { return (float)__builtin_bit_cast(h2_t, u).x; }
__device__ __forceinline__ float hhi(unsigned u) { return (float)__builtin_bit_cast(h2_t, u).y; }
struct EpiRes {
    static constexpr bool PERM = false, AFTER_DRAIN = false;
    const float *xp, *xs; float* out; const float* ada;
    float* part; unsigned* cnt;
    template <int AI> __device__ __forceinline__ void store_half(const pg8::f32x4 (&acc)[2][2][4][2], const float* gate, const float* xin, int row0, int col0) const {
        f32x4 g[2][2];
#pragma unroll
        for (int bj = 0; bj < 2; ++bj)
#pragma unroll
            for (int n = 0; n < 2; ++n) g[bj][n] = *(const f32x4*)(gate + bj * 128 + n * 16);
#pragma unroll
        for (int m = 0; m < 4; ++m) { const size_t off = (size_t)(row0 + AI * 128 + m * 16) * 1024 + col0;
#pragma unroll
            for (int bj = 0; bj < 2; ++bj)
#pragma unroll
                for (int n = 0; n < 2; ++n) { const f32x4 xv = *(const f32x4*)(xin + off + bj * 128 + n * 16); *(f32x4*)(out + off + bj * 128 + n * 16) = xv + g[bj][n] * acc[AI][bj][m][n]; } }
    }
    template <int AI> __device__ __forceinline__ void finish_split(pg8::f32x4 (&acc)[2][2][4][2], const pg8::Unit& u, __amdgpu_buffer_rsrc_t rs, unsigned lo, int wcu, const float* gate, const float* xin, int row0, int col0) const {
        const int j = u.part;
#pragma unroll
        for (int jj = 1; jj < 4; ++jj) {
            const int js = (j + jj) & 3;
            const unsigned sb = (unsigned)((((u.tix * 4 + js) * 3 + (3 - jj)) * 4 + wcu) * 8) * 1024u;
            v4u t[8];
#pragma unroll
            for (int r = 0; r < 8; ++r) t[r] = __builtin_amdgcn_raw_buffer_load_b128(rs, lo, sb + (unsigned)(r * 1024), 0);
#pragma unroll
            for (int r = 0; r < 8; ++r) { f32x4 a0 = acc[AI][r >> 2][r & 3][0], a1 = acc[AI][r >> 2][r & 3][1];
                a0.x += hlo(t[r].x); a0.y += hhi(t[r].x); a0.z += hlo(t[r].y); a0.w += hhi(t[r].y); a1.x += hlo(t[r].z); a1.y += hhi(t[r].z); a1.z += hlo(t[r].w); a1.w += hhi(t[r].w);
                asm volatile("" : "+v"(a0), "+v"(a1) :: "memory");
                acc[AI][r >> 2][r & 3][0] = a0; acc[AI][r >> 2][r & 3][1] = a1; } }
        store_half<AI>(acc, gate, xin, row0, col0);
    }
    __device__ __forceinline__ void operator()(pg8::f32x4 (&acc)[2][2][4][2], const pg8::Unit& u, int wr_, int wc_, int fr_, int fq_) const {
        int fr = fr_, fq = fq_, wr = wr_, wc = wc_; asm volatile("" : "+v"(fr), "+v"(fq), "+v"(wr), "+v"(wc));
        const int row0 = u.pm * 256 + wr * 64 + fr, col0 = u.pn * 256 + wc * 32 + 4 * fq;
        const int vec = (u.pm < 16) ? 0 : 1 + ((u.pm - 16) >> 4);
        const float* gate = ada + (size_t)vec * 3072 + 2048 + col0;
        const float* xin = (u.pm < 16) ? xp : xs;
        if (u.part >= 0) {
            const int j = u.part, lane = fq * 16 + fr, wru = __builtin_amdgcn_readfirstlane(wr), wcu = __builtin_amdgcn_readfirstlane(wc);
            const unsigned long long pa_ = (unsigned long long)part;
            float* part_u = (float*)(((unsigned long long)(unsigned)__builtin_amdgcn_readfirstlane((int)(pa_ >> 32)) << 32) | (unsigned)__builtin_amdgcn_readfirstlane((int)pa_));
            const __amdgpu_buffer_rsrc_t rs = __builtin_amdgcn_make_buffer_rsrc(part_u, 0, 24 << 20, 0x00020000); const unsigned lo = (unsigned)lane * 16u;
#pragma unroll
            for (int ai = 0; ai < 2; ++ai) { const int q = 2 * ai + wru;
                if (q != j) {
                    const unsigned base = (unsigned)((((u.tix * 4 + j) * 3 + ((q - j - 1) & 3)) * 4 + wcu) * 8) * 1024u;
#pragma unroll
                    for (int bj = 0; bj < 2; ++bj)
#pragma unroll
                        for (int m = 0; m < 4; ++m) { const f32x4 v0 = acc[ai][bj][m][0], v1 = acc[ai][bj][m][1]; v4u w; w.x = ph2x(v0.x, v0.y); w.y = ph2x(v0.z, v0.w); w.z = ph2x(v1.x, v1.y); w.w = ph2x(v1.z, v1.w);
                            __builtin_amdgcn_raw_buffer_store_b128(w, rs, lo, base + (unsigned)((bj * 4 + m) * 1024), 16  ); } } }
            asm volatile("s_waitcnt vmcnt(0)" ::: "memory");
            unsigned* c = cnt + u.tix * 32;
            if (lane == 0) (void)__hip_atomic_fetch_add(c, 1u, __ATOMIC_RELAXED, __HIP_MEMORY_SCOPE_AGENT);
            if (wru != (j & 1)) return;
            { unsigned sp = 0; while ((unsigned)__builtin_amdgcn_readfirstlane(__hip_atomic_load(c, __ATOMIC_RELAXED, __HIP_MEMORY_SCOPE_AGENT)) < 32u && ++sp < (1u << 22)) __builtin_amdgcn_s_sleep(1); }
            __builtin_amdgcn_fence(__ATOMIC_ACQUIRE, "agent");
            if ((j >> 1) == 0) finish_split<0>(acc, u, rs, lo, wcu, gate, xin, row0, col0); else finish_split<1>(acc, u, rs, lo, wcu, gate, xin, row0, col0);
            return;
        }
        store_half<0>(acc, gate, xin, row0, col0); store_half<1>(acc, gate, xin, row0, col0);
    }
};

struct EpiGate {
    static constexpr bool PERM = false, AFTER_DRAIN = false;
    bf16* pg;
    __device__ __forceinline__ void operator()(const pg8::f32x4 (&acc)[2][2][4][2], const pg8::Unit& u, int wr_, int wc_, int fr_, int fq_) const {
        int fr = fr_, fq = fq_, wr = wr_, wc = wc_; asm volatile("" : "+v"(fr), "+v"(fq), "+v"(wr), "+v"(wc));
        const int row0 = u.pm * 256 + wr * 64 + fr, ch0 = u.pn * 64 + 16 * wc + 4 * fq;
#pragma unroll
        for (int ai = 0; ai < 2; ++ai)
#pragma unroll
            for (int m = 0; m < 4; ++m) { bf16* rowp = pg + (size_t)(row0 + ai * 128 + m * 16) * 4096 + ch0;
                const f32x4 bg = acc[ai][0][m][0], cg = acc[ai][0][m][1], uu = acc[ai][1][m][0], z = acc[ai][1][m][1];
                const f32x4 pp = cg * uu, gt = bg * silu4(z);
                v2u w; w.x = pk2(pp[0], pp[1]); w.y = pk2(pp[2], pp[3]); *(v2u*)rowp = w;
                w.x = pk2(gt[0], gt[1]); w.y = pk2(gt[2], gt[3]); *(v2u*)(rowp + 2048) = w; }
    }
};

struct EpiGateConv {
    static constexpr bool PERM = false, AFTER_DRAIN = false;
    bf16* y2; float* sb; const float* cw; const float* cb; LAS float* xl;
    __device__ __forceinline__ void operator()(pg8::f32x4 (&acc)[2][2][4][2], const pg8::Unit& u, int wr_, int wc_, int fr_, int fq_) const {
        int fr = fr_, fq = fq_, wr = wr_, wc = wc_; asm volatile("" : "+v"(fr), "+v"(fq), "+v"(wr), "+v"(wc));
        const int row0 = u.pm * 256 + wr * 64 + fr, ch0 = u.pn * 64 + 16 * wc + 4 * fq, wid = wr * 4 + wc;
        const f32x4 w0 = *(const f32x4*)(cw + ch0), w1 = *(const f32x4*)(cw + 2048 + ch0), w2 = *(const f32x4*)(cw + 4096 + ch0), bb = *(const f32x4*)(cb + ch0);
#pragma unroll
        for (int ai = 0; ai < 2; ++ai) {
#pragma unroll
            for (int m = 0; m < 4; ++m) acc[ai][0][m][1] = acc[ai][0][m][1] * acc[ai][1][m][0];
            if (fr == 0)  *(LAS f32x4*)(xl + ((wid * 2 + ai) * 2 + 0) * 16 + 4 * fq) = acc[ai][0][0][1];
            if (fr == 15) *(LAS f32x4*)(xl + ((wid * 2 + ai) * 2 + 1) * 16 + 4 * fq) = acc[ai][0][3][1]; }
        asm volatile("s_waitcnt lgkmcnt(0)" ::: "memory"); __builtin_amdgcn_s_barrier();
        const int ow = wid ^ 4;
        const f32x4 z4 = {0.f, 0.f, 0.f, 0.f};
        f32x4 hp[2], hn[2];
        hp[0] = (wr == 0) ? z4 : *(const LAS f32x4*)(xl + ((ow * 2 + 0) * 2 + 1) * 16 + 4 * fq);
        hn[0] = (wr == 0) ? *(const LAS f32x4*)(xl + ((ow * 2 + 0) * 2 + 0) * 16 + 4 * fq) : *(const LAS f32x4*)(xl + ((ow * 2 + 1) * 2 + 0) * 16 + 4 * fq);
        hp[1] = (wr == 0) ? *(const LAS f32x4*)(xl + ((ow * 2 + 0) * 2 + 1) * 16 + 4 * fq) : *(const LAS f32x4*)(xl + ((ow * 2 + 1) * 2 + 1) * 16 + 4 * fq);
        hn[1] = (wr == 0) ? *(const LAS f32x4*)(xl + ((ow * 2 + 1) * 2 + 0) * 16 + 4 * fq) : z4;
        const bool f0 = (fr == 0), f15 = (fr == 15);
        v2u yw[4];
#pragma unroll
        for (int ai = 0; ai < 2; ++ai)
#pragma unroll
            for (int m = 0; m < 4; ++m) {
                const f32x4 c = acc[ai][0][m][1];
                f32x4 up, dn, pe, ne;
#pragma unroll
                for (int e = 0; e < 4; ++e) { up[e] = dppf<0x121>(c[e]); dn[e] = dppf<0x12F>(c[e]); }
                if (m > 0) {
#pragma unroll
                    for (int e = 0; e < 4; ++e) pe[e] = dppf<0x121>(acc[ai][0][m > 0 ? m - 1 : 0][1][e]); } else pe = hp[ai];
                if (m < 3) {
#pragma unroll
                    for (int e = 0; e < 4; ++e) ne[e] = dppf<0x12F>(acc[ai][0][m < 3 ? m + 1 : 3][1][e]); } else ne = hn[ai];
                const f32x4 pv = f0 ? pe : up, nx = f15 ? ne : dn;
                const f32x4 gt = acc[ai][0][m][0] * silu4(acc[ai][1][m][1]);
                const f32x4 y = gt * (w0 * pv + w1 * c + w2 * nx + bb);
                yw[m].x = pk2(y[0], y[1]); yw[m].y = pk2(y[2], y[3]);
                if (m & 1) {
                    typedef unsigned u2_t __attribute__((ext_vector_type(2)));
                    const u2_t s0 = __builtin_amdgcn_permlane16_swap(yw[m - (m & 1)].x, yw[m].x, false, false), s1 = __builtin_amdgcn_permlane16_swap(yw[m - (m & 1)].y, yw[m].y, false, false);
                    v4u w; w.x = s0[0]; w.y = s1[0]; w.z = s0[1]; w.w = s1[1];
                    *(v4u*)(y2 + (size_t)(row0 + ai * 128 + (m - 1 + (fq & 1)) * 16) * 2048 + ch0 - 4 * (fq & 1)) = w; }
                if (ai == 0 && m == 0) { if (wr == 0 && fr < 2) { float* d = sb + ((size_t)u.pm * 6 + fr) * 2048 + ch0; *(f32x4*)d = c; if (fr == 0) *(f32x4*)(d + 4 * 2048) = gt; } }
                if (ai == 1 && m == 3) { if (wr == 1 && fr >= 14) { float* d = sb + ((size_t)u.pm * 6 + 2 + (fr - 14)) * 2048 + ch0; *(f32x4*)d = c; if (fr == 15) *(f32x4*)(sb + ((size_t)u.pm * 6 + 5) * 2048 + ch0) = gt; } }
            }
    }
};
__device__ __forceinline__ void conv_fix_phase(const Params& p, int vcu, int G) {
    const float* sb = (const float*)(p.ws + WS_CSB); bf16* y2 = (bf16*)(p.ws + WS_YAB); const float* cw = p.in[I_CONVW]; const float* cb = p.in[I_CONVB];
    for (int it = vcu * NTHR + threadIdx.x; it < 60 * 2 * 512; it += G * NTHR) {
        const int c4 = (it & 511) * 4, side = (it >> 9) & 1, bd = it >> 10, seq = bd / 15, ta = 16 + seq * 16 + (bd % 15), tb = ta + 1;
        const float* A = sb + (size_t)ta * 6 * 2048 + c4; const float* B = sb + (size_t)tb * 6 * 2048 + c4;
        const f32x4 w0 = *(const f32x4*)(cw + c4), w1 = *(const f32x4*)(cw + 2048 + c4), w2 = *(const f32x4*)(cw + 4096 + c4), bb = *(const f32x4*)(cb + c4);
        f32x4 pv, c, nx, gt; int row;
        if (side == 0) { pv = *(const f32x4*)(A + 2 * 2048); c = *(const f32x4*)(A + 3 * 2048); nx = *(const f32x4*)(B); gt = *(const f32x4*)(A + 5 * 2048); row = ta * 256 + 255; }
        else           { pv = *(const f32x4*)(A + 3 * 2048); c = *(const f32x4*)(B); nx = *(const f32x4*)(B + 2048); gt = *(const f32x4*)(B + 4 * 2048); row = tb * 256; }
        const f32x4 y = gt * (w0 * pv + w1 * c + w2 * nx + bb);
        v2u w; w.x = pk2(y[0], y[1]); w.y = pk2(y[2], y[3]);
        *(v2u*)(y2 + (size_t)row * 2048 + c4) = w;
    }
}
constexpr int S3_LW = 16384, S3_LA = 24576;
constexpr int S3_XF = 0, S3_YF = 16384;
constexpr int S3_RAW = 34816;
constexpr int S3_LWD = 34816, S3_KK = 51200, S3_BB = 59392, S3_KD = 67584, S3_RR = 75776;
constexpr int S3_BKF = 83968, S3_VTF = 100352, S3_AKB = 108544, S3_TTF = 112640, S3_AOF = 116736, S3_ABB = 124928, S3_SF = 129024, S3_OBUF = 131072, S3_CST = 139264, S3_END = 141824;
constexpr int S3_CF = S3_END;
static_assert(S3_CF + 1280 <= LDS_MISC, "scan LDS map");
struct ScanPtrs { const bf16 *par, *pak, *pav, *pal; bf16 *ofp, *ofs, *ob; float* bn; const bf16* wupt; bf16* yab; float* smid; };
__device__ __forceinline__ unsigned pkh2(float lo, float hi) { typedef _Float16 h2_t __attribute__((ext_vector_type(2))); h2_t v = {(_Float16)lo, (_Float16)hi}; return __builtin_bit_cast(unsigned, v); }
__device__ __forceinline__ h8 cvt8(const f32x16& x, int o) { v4u w; w.x = pkh2(x[o], x[o + 1]); w.y = pkh2(x[o + 2], x[o + 3]); w.z = pkh2(x[o + 4], x[o + 5]); w.w = pkh2(x[o + 6], x[o + 7]); return __builtin_bit_cast(h8, w); }
#define SQ_HI(q) (((q) >> 2) & 1)
#define SQ_E(q) ((((q) >> 3) << 2) | ((q) & 3))

__device__ __forceinline__ void scan_chain(const Params& p, const ScanPtrs& sp, LAS unsigned char* lds, int chain, int half) {
    const int tid = threadIdx.x, lane = tid & 63; const int wid = __builtin_amdgcn_readfirstlane(tid >> 6);
    const bool smp = chain < 128; const int cc = smp ? chain : chain - 128;
    const int d = cc & 1, h = (cc >> 1) & 15, b = cc >> 5;
    const int T = smp ? TS : TP, tok0 = smp ? NTP + b * TS : b * TP;
    const int tb0 = (half == 1) ? 32 : 0, tb1 = (half == 0) ? 32 : T / 64, nseq = (half == 1) ? 4 : 2;
    __syncthreads();
    for (int i = tid; i < 640; i += NTHR) { const int a = i >> 6, j = i & 63, cj = h * 64 + j; float v;
        if (a == 0) v = p.in[I_MU][cj]; else if (a == 1) v = p.in[I_MU][1024 + cj]; else if (a == 2) v = p.in[I_MU][2048 + cj];
        else if (a == 3) v = p.in[I_MU][3072 + 64 * d + j]; else if (a == 4) v = p.in[I_MU][3200 + 64 * d + j];
        else if (a == 5) v = p.in[I_W0][d * 1024 + cj]; else if (a == 6) v = p.in[I_A0][d * 1024 + cj];
        else if (a == 7) v = p.in[I_KK][cj]; else if (a == 8) v = p.in[I_KA][cj]; else v = p.in[I_RK][cj];
        ((LAS float*)(lds + S3_CST))[i] = v; }
    const int r32o = lane & 31, hio = lane >> 5;
    f32x16 St[2];
    St[0] = (f32x16){}; St[1] = (f32x16){};
    if (wid < 2 && smp && half != 1) { const float* s0 = p.in[d ? I_SB : I_SF] + ((size_t)(b * 16 + h) * 64 + 32 * wid + r32o) * 64;
#pragma unroll
        for (int kt = 0; kt < 2; ++kt)
#pragma unroll
            for (int rg = 0; rg < 4; ++rg) { const f32x4 a = *(const f32x4*)(s0 + 32 * kt + 8 * rg + 4 * hio); St[kt][4 * rg] = a.x; St[kt][4 * rg + 1] = a.y; St[kt][4 * rg + 2] = a.z; St[kt][4 * rg + 3] = a.w; } }
    { const bool isv = (half == 1) && (wid >= 2);
      const float m0 = (isv && wid == 2) ? 1.f : 0.f, m1 = (isv && wid == 3) ? 1.f : 0.f;
      f32x16 e;
#pragma unroll
      for (int r = 0; r < 16; ++r) e[r] = (8 * (r >> 2) + 4 * hio + (r & 3) == r32o) ? 1.f : 0.f;
      St[0] = St[0] + e * m0; St[1] = St[1] + e * m1; }
    const unsigned lds0 = (unsigned)(uintptr_t)lds;
#define SC_DMA(tb_) do { const int tlo_ = d ? (T - 64 * ((tb_) + 1)) : (64 * (tb_)); int l_ = lane; asm volatile("" : "+v"(l_)); \
        for (int n_ = wid; n_ < 42; n_ += 8) { int sg_ = 8 * n_ + (l_ >> 3); sg_ = sg_ < 330 ? sg_ : 329; const int rho_ = sg_ / 5, arr_ = sg_ - 5 * rho_; \
            int t_ = tlo_ - 1 + rho_; t_ = t_ < 0 ? 0 : (t_ >= T ? T - 1 : t_); const size_t m_ = (size_t)(tok0 + t_); \
            const bf16* src_ = (arr_ == 0) ? sp.par + m_ * 1024 + h * 64 : (arr_ == 1) ? sp.pak + m_ * 1024 + h * 64 : (arr_ == 2) ? sp.pav + m_ * 1024 + h * 64 : (arr_ == 3) ? sp.pal + m_ * 256 + 64 * d : sp.pal + m_ * 256 + 128 + 64 * d; \
            glds16(src_ + (l_ & 7) * 8, (unsigned)__builtin_amdgcn_readfirstlane(lds0 + S3_RAW + n_ * 1024)); } } while (0)
#define SC_SIDE(tb_) do { int l_ = lane; asm volatile("" : "+v"(l_)); const int wq_ = wid - 4, pe_ = l_ >> 3, jg_ = l_ & 7; \
        const LAS float* cst_ = (const LAS float*)(lds + S3_CST) + 8 * jg_; const int tlo_ = d ? (T - 64 * ((tb_) + 1)) : (64 * (tb_)); \
        bf16x8 bf_[2][4][2];     \
        _Pragma("unroll") for (int mat_ = 0; mat_ < 2; ++mat_) { const bf16* wb_ = sp.wupt + ((size_t)(mat_ * 2 + d) * 1024 + h * 64) * 64 + (l_ & 15) * 64 + 8 * (l_ >> 4); \
            _Pragma("unroll") for (int nt_ = 0; nt_ < 4; ++nt_) { bf_[mat_][nt_][0] = *(const bf16x8*)(wb_ + 16 * nt_ * 64); bf_[mat_][nt_][1] = *(const bf16x8*)(wb_ + 16 * nt_ * 64 + 32); } } \
        _Pragma("unroll") for (int q_ = 0; q_ < 2; ++q_) { const int vw_ = 2 * wq_ + q_; \
            const int tmin_ = d ? (T - 1 - ((tb_) * 64 + 8 * vw_ + 7)) : ((tb_) * 64 + 8 * vw_); const int i_ = 8 * vw_ + (d ? (7 - pe_) : pe_), t_ = tmin_ + pe_; \
            const bool okp_ = t_ > 0, okn_ = t_ < T - 1; const LAS unsigned char* rw_ = lds + S3_RAW + (t_ - tlo_) * 640 + jg_ * 16; \
            _Pragma("unroll") for (int arr_ = 3; arr_ < 5; ++arr_) { v4u r0_ = *(const LAS v4u*)(rw_ + arr_ * 128), r1_ = *(const LAS v4u*)(rw_ + 640 + arr_ * 128), r2_ = *(const LAS v4u*)(rw_ + 1280 + arr_ * 128); \
                if (!okp_) r0_ = (v4u){0u, 0u, 0u, 0u}; if (!okn_) r2_ = (v4u){0u, 0u, 0u, 0u}; v4u o_; \
                _Pragma("unroll") for (int c2_ = 0; c2_ < 4; ++c2_) { \
                    const float xl_ = bflo(r1_[c2_]), xh_ = bfhi(r1_[c2_]); \
                    float yl_ = xl_ + cst_[64 * arr_ + 2 * c2_] * (0.5f * (bflo(r0_[c2_]) + bflo(r2_[c2_])) - xl_), yh_ = xh_ + cst_[64 * arr_ + 2 * c2_ + 1] * (0.5f * (bfhi(r0_[c2_]) + bfhi(r2_[c2_])) - xh_); \
                    if (arr_ == 3) { yl_ = 1.f - 2.f * frcp(1.f + __expf(2.f * yl_)); yh_ = 1.f - 2.f * frcp(1.f + __expf(2.f * yh_)); } \
                    o_[c2_] = pk2(yl_, yh_); } \
                *(LAS v4u*)(lds + (arr_ == 3 ? S3_LW : S3_LA) + (i_ * 64 + 8 * jg_) * 2) = o_; } } \
        asm volatile("s_waitcnt lgkmcnt(0)" ::: "memory"); \
        _Pragma("unroll") for (int mat_ = 0; mat_ < 2; ++mat_) { \
            const LAS unsigned char* ab_ = lds + (mat_ ? S3_LA : S3_LW) + ((16 * wq_ + (l_ & 15)) * 64 + 8 * (l_ >> 4)) * 2; \
            const bf16x8 a0_ = *(const LAS bf16x8*)ab_, a1_ = *(const LAS bf16x8*)(ab_ + 64); \
            f32x4 c_[4]; _Pragma("unroll") for (int nt_ = 0; nt_ < 4; ++nt_) { c_[nt_] = (f32x4){0.f, 0.f, 0.f, 0.f}; \
                c_[nt_] = __builtin_amdgcn_mfma_f32_16x16x32_bf16(a0_, bf_[mat_][nt_][0], c_[nt_], 0, 0, 0); c_[nt_] = __builtin_amdgcn_mfma_f32_16x16x32_bf16(a1_, bf_[mat_][nt_][1], c_[nt_], 0, 0, 0); } \
            asm volatile("s_waitcnt lgkmcnt(0)" ::: "memory");     \
            LAS unsigned short* out_ = (LAS unsigned short*)(lds + (mat_ ? S3_LA : S3_LW)) + (16 * wq_ + 4 * (l_ >> 4)) * 64 + (l_ & 15); \
              \
            _Pragma("unroll") for (int nt_ = 0; nt_ < 4; ++nt_) { const float bias_ = ((const LAS float*)(lds + S3_CST))[(mat_ ? 384 : 320) + 16 * nt_ + (l_ & 15)]; const float sc_ = mat_ ? 1.f : -0.6065306597126334f; \
                _Pragma("unroll") for (int r_ = 0; r_ < 4; ++r_) { const _Float16 hv_ = (_Float16)(sc_ * sigmf(bias_ + c_[nt_][r_])); out_[64 * r_ + 16 * nt_] = __builtin_bit_cast(unsigned short, hv_); } } } } while (0)
    SC_DMA(tb0);
    asm volatile("s_waitcnt vmcnt(0)" ::: "memory"); __syncthreads();
    if (wid >= 4) SC_SIDE(tb0);
    __syncthreads();
    for (int tb = tb0; tb < tb1; ++tb) {
        int ln = lane; asm volatile("" : "+v"(ln));
        const int r32 = ln & 31, hi = ln >> 5, pe = ln >> 3, jg = ln & 7;
        const int tmin = d ? (T - 1 - (tb * 64 + 8 * wid + 7)) : (tb * 64 + 8 * wid);
        const int i = 8 * wid + (d ? (7 - pe) : pe), t = tmin + pe;
        float rm[8], km[8], vm[8];
        { const LAS float* cst = (const LAS float*)(lds + S3_CST) + 8 * jg;
          const int tlo = d ? (T - 64 * (tb + 1)) : (64 * tb);
          const bool okp = t > 0, okn = t < T - 1;
          const LAS unsigned char* rw = lds + S3_RAW + (t - tlo) * 640 + jg * 16;
#pragma unroll
          for (int arr = 0; arr < 3; ++arr) { v4u r0 = *(const LAS v4u*)(rw + arr * 128), r1 = *(const LAS v4u*)(rw + 640 + arr * 128), r2 = *(const LAS v4u*)(rw + 1280 + arr * 128);
              if (!okp) r0 = (v4u){0u, 0u, 0u, 0u}; if (!okn) r2 = (v4u){0u, 0u, 0u, 0u};
#pragma unroll
              for (int c2 = 0; c2 < 4; ++c2) {
#pragma unroll
                  for (int hh = 0; hh < 2; ++hh) { const int jj = 2 * c2 + hh;
                      const float x = hh ? bfhi(r1[c2]) : bflo(r1[c2]), nb = hh ? (bfhi(r0[c2]) + bfhi(r2[c2])) : (bflo(r0[c2]) + bflo(r2[c2]));
                      const float y = x + cst[64 * arr + jj] * (0.5f * nb - x);
                      if (arr == 0) rm[jj] = y; else if (arr == 1) km[jj] = y; else vm[jj] = y; } } } }
        __syncthreads();
        { const LAS float* cst = (const LAS float*)(lds + S3_CST) + 8 * jg;
          const v4u lwv = *(const LAS v4u*)(lds + S3_LW + (i * 64 + 8 * jg) * 2), lav = *(const LAS v4u*)(lds + S3_LA + (i * 64 + 8 * jg) * 2);
          float lwd[8], av[8], kkr[8], kd[8]; float ssq = 0.f, bon = 0.f;
          const h8 lwh = __builtin_bit_cast(h8, lwv), lah = __builtin_bit_cast(h8, lav);
#pragma unroll
          for (int jj = 0; jj < 8; ++jj) {
              lwd[jj] = (float)lwh[jj];
              av[jj] = (float)lah[jj];
              kkr[jj] = km[jj] * cst[448 + jj]; ssq += kkr[jj] * kkr[jj];
              kd[jj] = km[jj] * (1.f + (av[jj] - 1.f) * cst[512 + jj]);
              bon += rm[jj] * kd[jj] * cst[576 + jj]; }
          ssq = sum8(ssq); bon = sum8(bon);
          const float rinv = frcp(fmaxf(__builtin_amdgcn_sqrtf(ssq), 1e-12f));
          if (jg == 0) sp.bn[(size_t)(tok0 + t) * 32 + h * 2 + d] = bon;
          *(LAS f32x4*)(lds + S3_LWD + (i * 64 + 8 * jg) * 4) = (f32x4){lwd[0], lwd[1], lwd[2], lwd[3]};
          *(LAS f32x4*)(lds + S3_LWD + (i * 64 + 8 * jg) * 4 + 16) = (f32x4){lwd[4], lwd[5], lwd[6], lwd[7]};
          v4u o;
#define SC_PACK(expr) do { _Pragma("unroll") for (int c2 = 0; c2 < 4; ++c2) { float x0, x1; { const int jj = 2 * c2; x0 = (expr); } { const int jj = 2 * c2 + 1; x1 = (expr); } o[c2] = pkh2(x0, x1); } } while (0)
          SC_PACK(kkr[jj] * rinv);                *(LAS v4u*)(lds + S3_KK + (i * 64 + 8 * jg) * 2) = o;
          SC_PACK(-(kkr[jj] * rinv) * av[jj]);    *(LAS v4u*)(lds + S3_BB + (i * 64 + 8 * jg) * 2) = o;
          SC_PACK(kd[jj]);                        *(LAS v4u*)(lds + S3_KD + (i * 64 + 8 * jg) * 2) = o;
          SC_PACK(rm[jj]);                        *(LAS v4u*)(lds + S3_RR + (i * 64 + 8 * jg) * 2) = o;
#undef SC_PACK
          { const int c = i >> 4, q = i & 15; LAS _Float16* vt = (LAS _Float16*)(lds + S3_VTF + c * 2048 + ((jg >> 2) * 32 + (jg & 3) * 8) * 32 + SQ_HI(q) * 16 + SQ_E(q) * 2);
#pragma unroll
            for (int jj = 0; jj < 8; ++jj) vt[jj * 16] = (_Float16)vm[jj]; }
        }
        __syncthreads();
        { const int c = wid >> 1, k = ln, ksx = k >> 4, q = k & 15, fo = SQ_HI(q) * 16 + SQ_E(q) * 2;
          float Lc[16];
          { float run = 0.f;
#pragma unroll
            for (int tau = 0; tau < 16; ++tau) { run += ((const LAS float*)(lds + S3_LWD))[(16 * c + tau) * 64 + k]; Lc[tau] = run; } }
          const float Lref = Lc[7];
          if ((wid & 1) == 0) {
              ((LAS float*)(lds + S3_SF))[(c * 2) * 64 + k] = __expf(Lref); ((LAS float*)(lds + S3_SF))[(c * 2 + 1) * 64 + k] = __expf(Lc[15] - Lref);
              LAS unsigned char* xf = lds + S3_XF + c * 4096 + ksx * 1024 + fo;
#pragma unroll
              for (int tau = 0; tau < 16; ++tau) { const float e1 = __expf((tau ? Lc[tau - 1] : 0.f) - Lref), e2 = __expf(Lc[tau] - Lref);
                  const float kkv = (float)((const LAS _Float16*)(lds + S3_KK))[(16 * c + tau) * 64 + k], rv = (float)((const LAS _Float16*)(lds + S3_RR))[(16 * c + tau) * 64 + k];
                  *(LAS _Float16*)(xf + ((tau + 2 * ksx) & 31) * 32) = (_Float16)(kkv * e1); *(LAS _Float16*)(xf + ((16 + tau + 2 * ksx) & 31) * 32) = (_Float16)(rv * e2); }
          } else {
              LAS unsigned char* yf = lds + S3_YF + c * 4096 + ksx * 1024 + fo;
              LAS unsigned char* bk = lds + S3_BKF + c * 4096 + (k >> 5) * 2048 + (k & 31) * 32;
              float bt[16], kt2[16];
#pragma unroll
              for (int tau = 0; tau < 16; ++tau) { const float e3 = __expf(Lref - Lc[tau]);
                  bt[tau] = (float)((const LAS _Float16*)(lds + S3_BB))[(16 * c + tau) * 64 + k] * e3; kt2[tau] = (float)((const LAS _Float16*)(lds + S3_KD))[(16 * c + tau) * 64 + k] * e3;
                  *(LAS _Float16*)(yf + ((tau + 2 * ksx) & 31) * 32) = (_Float16)bt[tau]; *(LAS _Float16*)(yf + ((16 + tau + 2 * ksx) & 31) * 32) = (_Float16)kt2[tau]; }
              *(LAS v4u*)(bk)             = (v4u){pkh2(bt[0], bt[1]), pkh2(bt[2], bt[3]), pkh2(bt[8], bt[9]), pkh2(bt[10], bt[11])};
              *(LAS v4u*)(bk + 16)        = (v4u){pkh2(bt[4], bt[5]), pkh2(bt[6], bt[7]), pkh2(bt[12], bt[13]), pkh2(bt[14], bt[15])};
              *(LAS v4u*)(bk + 1024)      = (v4u){pkh2(kt2[0], kt2[1]), pkh2(kt2[2], kt2[3]), pkh2(kt2[8], kt2[9]), pkh2(kt2[10], kt2[11])};
              *(LAS v4u*)(bk + 1024 + 16) = (v4u){pkh2(kt2[4], kt2[5]), pkh2(kt2[6], kt2[7]), pkh2(kt2[12], kt2[13]), pkh2(kt2[14], kt2[15])};
          } }
        __syncthreads();
        if (tb + 1 < tb1) SC_DMA(tb + 1);
        if (wid >= 4) { const int ci = tid - 256;
            for (int e = ci; e < 320; e += 256) { const int c = e >> 6, k = e & 63; const LAS float* sf = (const LAS float*)(lds + S3_SF);
                ((LAS float*)(lds + S3_CF))[e] = (c == 0) ? sf[k] : (c == 4) ? sf[7 * 64 + k] : sf[(2 * c) * 64 + k] * sf[(2 * c - 1) * 64 + k]; } }
        if (wid < 4) { const int c = wid, fl = r32 * 32 + hi * 16;
            f32x16 G = (f32x16){};
#pragma unroll
            for (int ks = 0; ks < 4; ++ks) { const int flr = ((r32 + 2 * ks) & 31) * 32 + hi * 16;
                G = __builtin_amdgcn_mfma_f32_32x32x16_f16(*(const LAS h8*)(lds + S3_YF + c * 4096 + ks * 1024 + flr), *(const LAS h8*)(lds + S3_XF + c * 4096 + ks * 1024 + flr), G, 0, 0, 0); }
            const int n = r32, tau = n & 15; const bool isr = n >= 16;
#pragma unroll
            for (int r = 0; r < 16; ++r) { const int j = (r & 3) + 8 * ((r >> 2) & 1) + 4 * hi; const bool keep = isr ? (j <= tau) : (j < tau); G[r] = keep ? G[r] : 0.f; }
            const h8 z8 = (h8){};
            if (!isr) {
#pragma unroll
                for (int r = 0; r < 8; ++r) { const int j = (r & 3) + 8 * (r >> 2) + 4 * hi; ((LAS float*)(lds + S3_ABB))[c * 256 + j * 16 + tau] = G[r]; }
                *(LAS h8*)(lds + S3_AKB + c * 1024 + fl) = cvt8(G, 8);
                *(LAS h8*)(lds + S3_AOF + c * 2048 + fl) = z8; *(LAS h8*)(lds + S3_AOF + c * 2048 + 1024 + fl) = z8;
            } else {
                *(LAS h8*)(lds + S3_AKB + c * 1024 + fl) = z8;
                *(LAS h8*)(lds + S3_AOF + c * 2048 + fl) = cvt8(G, 0); *(LAS h8*)(lds + S3_AOF + c * 2048 + 1024 + fl) = cvt8(G, 8);
            }
            asm volatile("s_waitcnt lgkmcnt(0)" ::: "memory");
            { const int ii = ln & 15; float Tc[16]; const LAS float* ab = (const LAS float*)(lds + S3_ABB) + c * 256;
#pragma unroll
              for (int ta = 15; ta >= 0; --ta) { float acc0 = (ta == ii) ? 1.f : 0.f, acc1 = 0.f, acc2 = 0.f, acc3 = 0.f;
                  if ((ta & 3) == 3) asm volatile("" ::: "memory");
#pragma unroll
                  for (int m = ta + 1; m < 16; ++m) { const float pr = ab[ta * 16 + m] * Tc[m]; if ((m & 3) == 0) acc0 += pr; else if ((m & 3) == 1) acc1 += pr; else if ((m & 3) == 2) acc2 += pr; else acc3 += pr; }
                  Tc[ta] = (acc0 + acc1) + (acc2 + acc3); }
              v4u w0, w1;
              w0.x = pkh2(Tc[0], Tc[1]); w0.y = pkh2(Tc[2], Tc[3]); w0.z = pkh2(Tc[8], Tc[9]); w0.w = pkh2(Tc[10], Tc[11]);
              w1.x = pkh2(Tc[4], Tc[5]); w1.y = pkh2(Tc[6], Tc[7]); w1.z = pkh2(Tc[12], Tc[13]); w1.w = pkh2(Tc[14], Tc[15]);
              if (ln < 16) { *(LAS v4u*)(lds + S3_TTF + c * 1024 + ln * 32) = w0; *(LAS v4u*)(lds + S3_TTF + c * 1024 + ln * 32 + 16) = w1; }
              else if (ln < 32) { *(LAS v4u*)(lds + S3_TTF + c * 1024 + ln * 32) = (v4u){0u, 0u, 0u, 0u}; *(LAS v4u*)(lds + S3_TTF + c * 1024 + ln * 32 + 16) = (v4u){0u, 0u, 0u, 0u}; } }
        }
        asm volatile("s_waitcnt vmcnt(0)" ::: "memory");
        __syncthreads();
        if (wid >= 4 && tb + 1 < tb1) SC_SIDE(tb + 1);
        if (wid < nseq) { const int fl = r32 * 32 + hi * 16; const bool virt = wid >= 2; const int vtile = wid & 1;
#pragma unroll 1
            for (int c = 0; c < 4; ++c) {
                f32x4 cf[8];
#pragma unroll
                for (int kt = 0; kt < 2; ++kt)
#pragma unroll
                    for (int rg = 0; rg < 4; ++rg) cf[kt * 4 + rg] = *(const LAS f32x4*)(lds + S3_CF + c * 256 + (32 * kt + 8 * rg + 4 * hi) * 4);
                const LAS unsigned char* xf = lds + S3_XF + c * 4096 + hi * 16;
                const h8 x0 = *(const LAS h8*)(xf + r32 * 32), x1 = *(const LAS h8*)(xf + 1024 + ((r32 + 2) & 31) * 32), x2 = *(const LAS h8*)(xf + 2048 + ((r32 + 4) & 31) * 32), x3 = *(const LAS h8*)(xf + 3072 + ((r32 + 6) & 31) * 32);
                h8 vfr = *(const LAS h8*)(lds + S3_VTF + c * 2048 + vtile * 1024 + fl); if (virt) vfr = (h8){};
                const h8 akb = *(const LAS h8*)(lds + S3_AKB + c * 1024 + fl), ttf = *(const LAS h8*)(lds + S3_TTF + c * 1024 + fl);
                const h8 ao0 = *(const LAS h8*)(lds + S3_AOF + c * 2048 + fl), ao1 = *(const LAS h8*)(lds + S3_AOF + c * 2048 + 1024 + fl);
                const h8 bk00 = *(const LAS h8*)(lds + S3_BKF + c * 4096 + fl), bk01 = *(const LAS h8*)(lds + S3_BKF + c * 4096 + 1024 + fl),
                         bk10 = *(const LAS h8*)(lds + S3_BKF + c * 4096 + 2048 + fl), bk11 = *(const LAS h8*)(lds + S3_BKF + c * 4096 + 3072 + fl);
#pragma unroll
                for (int kt = 0; kt < 2; ++kt)
#pragma unroll
                    for (int rg = 0; rg < 4; ++rg) { const f32x4 f = cf[kt * 4 + rg]; St[kt][4 * rg] *= f.x; St[kt][4 * rg + 1] *= f.y; St[kt][4 * rg + 2] *= f.z; St[kt][4 * rg + 3] *= f.w; }
                const h8 s0 = cvt8(St[0], 0), s1 = cvt8(St[0], 8), s2 = cvt8(St[1], 0), s3 = cvt8(St[1], 8);
                f32x16 P = __builtin_amdgcn_mfma_f32_32x32x16_f16(akb, vfr, (f32x16){}, 0, 0, 0);
                P = __builtin_amdgcn_mfma_f32_32x32x16_f16(x0, s0, P, 0, 0, 0);
                P = __builtin_amdgcn_mfma_f32_32x32x16_f16(x1, s1, P, 0, 0, 0);
                P = __builtin_amdgcn_mfma_f32_32x32x16_f16(x2, s2, P, 0, 0, 0);
                P = __builtin_amdgcn_mfma_f32_32x32x16_f16(x3, s3, P, 0, 0, 0);
                const h8 zf = cvt8(P, 0);
                f32x16 Ut = __builtin_amdgcn_mfma_f32_32x32x16_f16(ttf, zf, (f32x16){}, 0, 0, 0);
                const h8 uf = cvt8(Ut, 0);
                St[0] = __builtin_amdgcn_mfma_f32_32x32x16_f16(bk00, uf, St[0], 0, 0, 0);
                St[1] = __builtin_amdgcn_mfma_f32_32x32x16_f16(bk10, uf, St[1], 0, 0, 0);
                St[0] = __builtin_amdgcn_mfma_f32_32x32x16_f16(bk01, vfr, St[0], 0, 0, 0);
                St[1] = __builtin_amdgcn_mfma_f32_32x32x16_f16(bk11, vfr, St[1], 0, 0, 0);
                P = __builtin_amdgcn_mfma_f32_32x32x16_f16(ao0, uf, P, 0, 0, 0);
                P = __builtin_amdgcn_mfma_f32_32x32x16_f16(ao1, vfr, P, 0, 0, 0);
                if (!virt) {
#pragma unroll
                    for (int r = 8; r < 16; ++r) { const int tau = (r & 3) + 8 * ((r >> 2) & 1) + 4 * hi;
                        *(LAS unsigned short*)(lds + S3_OBUF + ((16 * c + tau) * 64 + 32 * vtile + r32) * 2) = (unsigned short)f2bf(P[r]); }
                } else {
                    _Float16* mt = (_Float16*)(sp.yab + ((size_t)(NTP + b * TS + (tb * 64 + 16 * c - 2048) + 2048 * d) * 2048 + 1024)) + h * 64 + 32 * vtile + r32;
#pragma unroll
                    for (int r = 8; r < 16; ++r) { const int tau = (r & 3) + 8 * ((r >> 2) & 1) + 4 * hi; mt[(size_t)tau * 2048] = (_Float16)P[r]; }
                }
            }
#pragma unroll
            for (int kt = 0; kt < 2; ++kt)
#pragma unroll
                for (int rg = 0; rg < 4; ++rg) { const f32x4 f = *(const LAS f32x4*)(lds + S3_CF + 4 * 256 + (32 * kt + 8 * rg + 4 * hi) * 4);
                    St[kt][4 * rg] *= f.x; St[kt][4 * rg + 1] *= f.y; St[kt][4 * rg + 2] *= f.z; St[kt][4 * rg + 3] *= f.w; }
        }
        __syncthreads();
        { const int fi = tid >> 3, ch = tid & 7; const int ft = d ? (T - 1 - (tb * 64 + fi)) : (tb * 64 + fi);
          const v4u v = *(const LAS v4u*)(lds + S3_OBUF + (fi * 64 + ch * 8) * 2);
          bf16* dst = d ? (sp.ob + (size_t)(tok0 + ft) * 1024) : (smp ? sp.ofs + (size_t)(b * TS + ft) * 1024 : sp.ofp + (size_t)(tok0 + ft) * 1024);
          *(v4u*)(dst + h * 64 + ch * 8) = v; }
    }
#undef SC_DMA
#undef SC_SIDE
    if (wid < 2 && half != 1) { float* o = smp ? sp.smid + ((size_t)chain * 64 + 32 * wid + r32o) * 64 : (float*)((unsigned char*)p.out + (d ? O_SB : O_SF)) + ((size_t)(b * 16 + h) * 64 + 32 * wid + r32o) * 64;
#pragma unroll
        for (int kt = 0; kt < 2; ++kt)
#pragma unroll
            for (int rg = 0; rg < 4; ++rg) *(f32x4*)(o + 32 * kt + 8 * rg + 4 * hio) = (f32x4){St[kt][4 * rg], St[kt][4 * rg + 1], St[kt][4 * rg + 2], St[kt][4 * rg + 3]}; }
}
__device__ __forceinline__ void scan_phase(const Params& p, LAS unsigned char* lds, int vcu, int G) {
    ScanPtrs sp; sp.par = (const bf16*)(p.ws + X_PAR); sp.pak = (const bf16*)(p.ws + X_PAK); sp.pav = (const bf16*)((unsigned char*)p.out + O_PAV); sp.pal = (const bf16*)(p.ws + X_PAL);
    sp.ofp = (bf16*)(p.ws + X_OFP); sp.ofs = (bf16*)((unsigned char*)p.out + O_OFS); sp.ob = (bf16*)((unsigned char*)p.out + O_OB); sp.bn = (float*)(p.ws + WS_BN); sp.wupt = (const bf16*)(p.ws + WS_WUPT);
    sp.yab = (bf16*)(p.ws + WS_YAB); sp.smid = (float*)(p.ws + X_SMID);
    for (int j = vcu; j < 768; j += G) { const int chain = (j < 256) ? (j >> 1) : 128 + (j - 256), half = (j < 256) ? (j & 1) : -1; scan_chain(p, sp, lds, chain, half); }
}
__device__ __forceinline__ void scan_fixup_phase(const Params& p, int vcu, int G) {
    const int lane = threadIdx.x & 63, r32 = lane & 31, hi = lane >> 5; const int wid = __builtin_amdgcn_readfirstlane(threadIdx.x >> 6);
    const bf16* yab = (const bf16*)(p.ws + WS_YAB); const float* smid = (const float*)(p.ws + X_SMID);
    bf16* ofs = (bf16*)((unsigned char*)p.out + O_OFS); bf16* ob = (bf16*)((unsigned char*)p.out + O_OB);
    for (int it = vcu; it < 1024; it += G) { const int chain = it >> 3, slab = it & 7, d = chain & 1, h = (chain >> 1) & 15, b = chain >> 5;
        const int pp = slab * 256 + wid * 32 + r32;
        const _Float16* mrow = (const _Float16*)(yab + ((size_t)(NTP + b * TS + pp + 2048 * d) * 2048 + 1024)) + h * 64 + 8 * hi;
        h8 mf[4];
#pragma unroll
        for (int ks = 0; ks < 4; ++ks) mf[ks] = *(const h8*)(mrow + 16 * ks);
        const int t = d ? (2047 - pp) : (2048 + pp);
        bf16* orow = (d ? ob + (size_t)(NTP + b * TS + t) * 1024 : ofs + (size_t)(b * TS + t) * 1024) + h * 64 + 4 * hi;
#pragma unroll
        for (int vt = 0; vt < 2; ++vt) { const float* srow = smid + ((size_t)chain * 64 + 32 * vt + r32) * 64 + 8 * hi;
            f32x16 D = (f32x16){};
#pragma unroll
            for (int ks = 0; ks < 4; ++ks) { const f32x4 a = *(const f32x4*)(srow + 16 * ks), c = *(const f32x4*)(srow + 16 * ks + 4);
                v4u w; w.x = pkh2(a.x, a.y); w.y = pkh2(a.z, a.w); w.z = pkh2(c.x, c.y); w.w = pkh2(c.z, c.w);
                D = __builtin_amdgcn_mfma_f32_32x32x16_f16(__builtin_bit_cast(h8, w), mf[ks], D, 0, 0, 0); }
#pragma unroll
            for (int g4 = 0; g4 < 4; ++g4) { bf16* o = orow + 32 * vt + 8 * g4; const v2u cur = *(const v2u*)o;
                v2u w; w.x = pk2(bflo(cur.x) + D[4 * g4], bfhi(cur.x) + D[4 * g4 + 1]); w.y = pk2(bflo(cur.y) + D[4 * g4 + 2], bfhi(cur.y) + D[4 * g4 + 3]); *(v2u*)o = w; } }
    }
}
__device__ __forceinline__ void post_scan_phase(const Params& p, int vcu, int G) {
    const int lane = threadIdx.x & 63, wid = threadIdx.x >> 6, gw = vcu * NWAVES + wid, NGW = G * NWAVES;
    const bf16* pav = (const bf16*)((unsigned char*)p.out + O_PAV); const bf16* ofp = (const bf16*)(p.ws + X_OFP); const bf16* ofs = (const bf16*)((unsigned char*)p.out + O_OFS);
    const bf16* ob = (const bf16*)((unsigned char*)p.out + O_OB); const float* bn = (const float*)(p.ws + WS_BN); bf16* yab = (bf16*)(p.ws + WS_YAB);
    for (int it = gw; it < NT * 4; it += NGW) {
        const int m = it >> 2, c0 = (it & 3) * 256 + 4 * lane, head = c0 >> 6;
        const int T = (m < NTP) ? TP : TS, t = (m < NTP) ? (m & 255) : ((m - NTP) & 4095);
        const v2u of = (m < NTP) ? *(const v2u*)(ofp + (size_t)m * 1024 + c0) : *(const v2u*)(ofs + (size_t)(m - NTP) * 1024 + c0);
        const v2u obv = *(const v2u*)(ob + (size_t)m * 1024 + c0);
        float o[4] = {bflo(of.x) + bflo(obv.x), bfhi(of.x) + bfhi(obv.x), bflo(of.y) + bflo(obv.y), bfhi(of.y) + bfhi(obv.y)};
        const float mean = sum16((o[0] + o[1]) + (o[2] + o[3])) * (1.f / 64.f);
        float dv[4], q = 0.f;
#pragma unroll
        for (int e = 0; e < 4; ++e) { dv[e] = o[e] - mean; q += dv[e] * dv[e]; }
        const float rs = rsqrtf(sum16(q) * (1.f / 64.f) + 64e-5f);
        const v2u vc = *(const v2u*)(pav + (size_t)m * 1024 + c0);
        v2u vp = {0u, 0u}, vn = {0u, 0u};
        if (t > 0) vp = *(const v2u*)(pav + (size_t)(m - 1) * 1024 + c0);
        if (t < T - 1) vn = *(const v2u*)(pav + (size_t)(m + 1) * 1024 + c0);
        const f32x4 muv = *(const f32x4*)(p.in[I_MU] + 2048 + c0), lw = *(const f32x4*)(p.in[I_LNW] + c0), lb = *(const f32x4*)(p.in[I_LNB] + c0);
        const float vcf[4] = {bflo(vc.x), bfhi(vc.x), bflo(vc.y), bfhi(vc.y)}, vpf[4] = {bflo(vp.x), bfhi(vp.x), bflo(vp.y), bfhi(vp.y)}, vnf[4] = {bflo(vn.x), bfhi(vn.x), bflo(vn.y), bfhi(vn.y)};
        const float bsum = bn[(size_t)m * 32 + head * 2] + bn[(size_t)m * 32 + head * 2 + 1];
        const v2u gav = *(const v2u*)(yab + (size_t)m * 2048 + c0);
        const float ga[4] = {bflo(gav.x), bfhi(gav.x), bflo(gav.y), bfhi(gav.y)};
        float y[4];
#pragma unroll
        for (int e = 0; e < 4; ++e) { const float vmix = vcf[e] + muv[e] * (0.5f * (vpf[e] + vnf[e]) - vcf[e]); y[e] = (dv[e] * rs * lw[e] + lb[e] + bsum * vmix) * ga[e]; }
        v2u w; w.x = pk2(y[0], y[1]); w.y = pk2(y[2], y[3]);
        *(v2u*)(yab + (size_t)m * 2048 + c0) = w;
    }
}
constexpr int AT_K = 0, AT_V = 49152, AT_SLOT = 16384, AT_X = 0;
#define AT_WAIT_BAR(N) asm volatile("s_waitcnt vmcnt(" #N ") lgkmcnt(0)\n\ts_barrier" ::: "memory")
__device__ __forceinline__ unsigned cvtpk(float lo, float hi) { typedef float f2_t __attribute__((ext_vector_type(2))); typedef __bf16 b2_t __attribute__((ext_vector_type(2))); f2_t v = {lo, hi}; b2_t b = __builtin_convertvector(v, b2_t); return __builtin_bit_cast(unsigned, b); }
__device__ __forceinline__ s16x4 vtr(const LAS unsigned char* p) { typedef short v4i16_t __attribute__((ext_vector_type(4))); return __builtin_bit_cast(s16x4, __builtin_amdgcn_ds_read_tr16_b64_v4i16((LAS v4i16_t*)p)); }
struct AttnCtx { const bf16 *q, *kp, *ks, *vp, *vs; bf16* yab; const float *kmax, *subln; float lam, kbase; };

__device__ __forceinline__ void attn_unit(const AttnCtx& A, LAS unsigned char* lds, int u) {
    const int tid = threadIdx.x, lane = tid & 63, r32 = lane & 31, hi = lane >> 5; const int wid = __builtin_amdgcn_readfirstlane(tid >> 6);
    const int qg = wid >> 1, comp = wid & 1;
    const bool smp = u < 1024; int b, h, qb;
    if (smp) { const int combo = u >> 5; b = combo >> 3; h = combo & 7; qb = u & 31; } else { const int pu = u - 1024; b = pu >> 4; h = (pu >> 1) & 7; qb = pu & 1; }
    const int tokq0 = (smp ? NTP + b * TS : b * TP) + qb * 128;
    const bf16* Km = smp ? A.ks + (size_t)b * TKS * 1024 : A.kp + (size_t)b * TP * 1024;
    const bf16* Vm = smp ? A.vs + (size_t)b * TKS * 1024 : A.vp + (size_t)b * TP * 1024;
    const int nkt = smp ? (TKS / 64) : (TP / 64);
    const bf16* ksrc0 = Km + (size_t)lane * 1024 + h * 128 + wid * 8;
    const bf16* vsrc0 = Vm + (size_t)(16 * (wid & 3) + (lane >> 2)) * 1024 + h * 128 + (wid >> 2) * 32 + (lane & 3) * 8;
    const unsigned lds0 = (unsigned)(uintptr_t)lds;
#define AT_DMA(t, slot) do { const size_t go_ = (size_t)(t) * 64 * 1024; \
        glds16(ksrc0 + go_,      (unsigned)__builtin_amdgcn_readfirstlane(lds0 + AT_K + (slot) * AT_SLOT + wid * 1024)); \
        glds16(ksrc0 + go_ + 64, (unsigned)__builtin_amdgcn_readfirstlane(lds0 + AT_K + (slot) * AT_SLOT + (wid + 8) * 1024)); \
        glds16(vsrc0 + go_,      (unsigned)__builtin_amdgcn_readfirstlane(lds0 + AT_V + (slot) * AT_SLOT + wid * 1024)); \
        glds16(vsrc0 + go_ + 64, (unsigned)__builtin_amdgcn_readfirstlane(lds0 + AT_V + (slot) * AT_SLOT + (wid + 8) * 1024)); } while (0)
    AT_DMA(0, 0);
    bf16x8 qf[4];
    const bf16* qrow = A.q + (size_t)(tokq0 + qg * 32 + r32) * 1024 + h * 128 + comp * 64 + hi * 8;
#pragma unroll
    for (int d0 = 0; d0 < 4; ++d0) qf[d0] = *(const bf16x8*)(qrow + d0 * 16);
    float mq;
    { float ss0 = 0.f;
#pragma unroll
      for (int d0 = 0; d0 < 4; ++d0)
#pragma unroll
          for (int e = 0; e < 8; ++e) { const float x0 = bf2f((unsigned short)qf[d0][e]); ss0 += x0 * x0; }
      ss0 += __shfl_xor(ss0, 32);
      float kb0 = A.kbase;
      if (smp) kb0 = fmaxf(kb0, sqrtf(A.kmax[(b * 8 + h) * 2 + comp]) * 1.01f);
      mq = sqrtf(ss0) * kb0; }
    f32x16 negm;
#pragma unroll
    for (int r = 0; r < 16; ++r) negm[r] = -mq;
    f32x16 O[4];
#pragma unroll
    for (int i = 0; i < 4; ++i) O[i] = (f32x16){};
    float l = 0.f;
    const int vbase = ((lane >> 4) & 1) * 32 + (lane & 3) * 8 + (4 * hi + ((lane & 15) >> 2)) * 64;
    int slot = 0;
    for (int t = 0; t < nkt; ++t) {
        const int nslot = (slot == 2) ? 0 : slot + 1;
        if (t + 1 < nkt) { AT_DMA(t + 1, nslot); AT_WAIT_BAR(4); } else { AT_WAIT_BAR(0); }
        const LAS unsigned char* Ks = lds + AT_K + slot * AT_SLOT + (comp * 8 + hi) * 1024 + r32 * 16;
        const LAS unsigned char* Vs = lds + AT_V + slot * AT_SLOT + vbase;
        bf16x8 pw[4];
#pragma unroll
        for (int kh = 0; kh < 2; ++kh) {
            f32x16 s; bf16x8 kf[4];
#pragma unroll
            for (int d0 = 0; d0 < 4; ++d0) kf[d0] = *(const LAS bf16x8*)(Ks + d0 * 2048 + kh * 512);
            s = __builtin_amdgcn_mfma_f32_32x32x16_bf16(kf[0], qf[0], negm, 0, 0, 0);
#pragma unroll
            for (int d0 = 1; d0 < 4; ++d0) s = __builtin_amdgcn_mfma_f32_32x32x16_bf16(kf[d0], qf[d0], s, 0, 0, 0);
            float ls = 0.f;
#pragma unroll
            for (int r = 0; r < 16; ++r) { s[r] = __builtin_amdgcn_exp2f(s[r]); ls += s[r]; }
            l += ls;
#pragma unroll
            for (int sx = 0; sx < 2; ++sx) { v4u w; w.x = cvtpk(s[8 * sx + 0], s[8 * sx + 1]); w.y = cvtpk(s[8 * sx + 2], s[8 * sx + 3]); w.z = cvtpk(s[8 * sx + 4], s[8 * sx + 5]); w.w = cvtpk(s[8 * sx + 6], s[8 * sx + 7]);
                pw[2 * kh + sx] = __builtin_bit_cast(bf16x8, w); }
        }
#pragma unroll
        for (int dvb = 0; dvb < 4; ++dvb) { bf16x8 vf[4];
#pragma unroll
            for (int ks = 0; ks < 4; ++ks) { const s16x4 lo = vtr(Vs + dvb * 4096 + ks * 1024), hh = vtr(Vs + dvb * 4096 + ks * 1024 + 512);
                vf[ks] = (bf16x8){lo[0], lo[1], lo[2], lo[3], hh[0], hh[1], hh[2], hh[3]}; }
#pragma unroll
            for (int ks = 0; ks < 4; ++ks) O[dvb] = __builtin_amdgcn_mfma_f32_32x32x16_bf16(vf[ks], pw[ks], O[dvb], 0, 0, 0);
        }
        slot = nslot;
    }
    l += __shfl_xor(l, 32);
    const float il = (comp ? A.lam : 1.f) / l;
    AT_WAIT_BAR(0);
    LAS float* xb = (LAS float*)(lds + AT_X + qg * 16384) + lane;
    if (comp == 1) {
#pragma unroll
        for (int dvb = 0; dvb < 4; ++dvb)
#pragma unroll
            for (int r = 0; r < 16; ++r) xb[(dvb * 16 + r) * 64] = O[dvb][r] * il;
    }
    AT_WAIT_BAR(0);
    if (comp == 0) {
        float ss = 0.f;
#pragma unroll
        for (int dvb = 0; dvb < 4; ++dvb)
#pragma unroll
            for (int r = 0; r < 16; ++r) { const float o = O[dvb][r] * il - xb[(dvb * 16 + r) * 64]; O[dvb][r] = o; ss += o * o; }
        ss += __shfl_xor(ss, 32);
        const float rinv = rsqrtf(ss * (1.f / 128.f) + 1e-6f) * 0.8f;
        bf16* yrow = A.yab + (size_t)(tokq0 + qg * 32 + r32) * 2048 + 1024 + h * 128 + 4 * hi;
#pragma unroll
        for (int dvb = 0; dvb < 4; ++dvb)
#pragma unroll
            for (int gq = 0; gq < 4; ++gq) { const int dv0 = 32 * dvb + 8 * gq;
                const v2u gb = *(const v2u*)(yrow + dv0); const f32x4 sw = *(const f32x4*)(A.subln + dv0 + 4 * hi);
                const float y0 = O[dvb][4 * gq + 0] * rinv * sw[0] * bflo(gb.x), y1 = O[dvb][4 * gq + 1] * rinv * sw[1] * bfhi(gb.x),
                            y2 = O[dvb][4 * gq + 2] * rinv * sw[2] * bflo(gb.y), y3 = O[dvb][4 * gq + 3] * rinv * sw[3] * bfhi(gb.y);
                v2u w; w.x = pk2(y0, y1); w.y = pk2(y2, y3); *(v2u*)(yrow + dv0) = w; }
    }
    AT_WAIT_BAR(0);
#undef AT_DMA
}
__device__ __forceinline__ void attn_phase(const Params& p, LAS unsigned char* lds, int vcu, int G) {
    AttnCtx A; A.q = (const bf16*)(p.ws + X_Q); A.kp = (const bf16*)(p.ws + X_KP); A.ks = (const bf16*)(p.ws + X_KS);
    A.vp = (const bf16*)((unsigned char*)p.out + O_VP); A.vs = (const bf16*)((unsigned char*)p.out + O_VS); A.yab = (bf16*)(p.ws + WS_YAB);
    A.kmax = (const float*)(p.ws + WS_KMAX); A.subln = p.in[I_SUBLN];
    const int lane = threadIdx.x & 63;
    { const float* lv = p.in[I_LAM]; const float s01 = wave_sum(lv[lane] * lv[64 + lane]), s23 = wave_sum(lv[128 + lane] * lv[192 + lane]);
      A.lam = __expf(s01) - __expf(s23) + 0.2f;
      A.kbase = 8.f * wave_max(fabsf(p.in[I_KN][lane])) * 1.01f; }
    for (int u = vcu; u < 1280; u += G) attn_unit(A, lds, u);
}
__device__ __forceinline__ void ctx_convert(const Params& p, int vcu, int G) {
    bf16* ks = (bf16*)(p.ws + X_KS); bf16* vs = (bf16*)((unsigned char*)p.out + O_VS);
    const int n = 2 * 4 * 256 * 256;
    for (int i = vcu * NTHR + threadIdx.x; i < n; i += G * NTHR) {
        const int tsr = i >> 18, rem = i & 262143, b = rem >> 16, t = (rem >> 8) & 255, c4 = rem & 255;
        const f32x4 v = *(const f32x4*)((tsr ? p.in[I_CV] : p.in[I_CK]) + ((size_t)(b * 256 + t) * 1024 + c4 * 4));
        v2u w; w.x = pk2(v.x, v.y); w.y = pk2(v.z, v.w);
        *(v2u*)((tsr ? vs : ks) + ((size_t)b * TKS + 4096 + t) * 1024 + c4 * 4) = w;
    }
}
__device__ __forceinline__ void conv_phase(const Params& p, int vcu, int G) {
    const int lane = threadIdx.x & 63, wid = threadIdx.x >> 6, gw = vcu * NWAVES + wid, NGW = G * NWAVES;
    bf16* pg = (bf16*)(p.ws + WS_PG); const float* cw = p.in[I_CONVW]; const float* cb = p.in[I_CONVB];
    for (int it = gw; it < NT * 4; it += NGW) {
        const int m = it >> 2, c0 = (it & 3) * 512 + 8 * lane;
        const int T = (m < NTP) ? TP : TS, t = (m < NTP) ? (m & 255) : ((m - NTP) & 4095);
        const v4u pc = *(const v4u*)(pg + (size_t)m * 4096 + c0), gt = *(const v4u*)(pg + (size_t)m * 4096 + 2048 + c0);
        v4u pp = {0u, 0u, 0u, 0u}, pn = {0u, 0u, 0u, 0u};
        if (t > 0) pp = *(const v4u*)(pg + (size_t)(m - 1) * 4096 + c0);
        if (t < T - 1) pn = *(const v4u*)(pg + (size_t)(m + 1) * 4096 + c0);
        v4u o;
#pragma unroll
        for (int e = 0; e < 4; ++e) { const int c = c0 + 2 * e;
            const float y0 = bflo(gt[e]) * (cw[c] * bflo(pp[e]) + cw[2048 + c] * bflo(pc[e]) + cw[4096 + c] * bflo(pn[e]) + cb[c]);
            const float y1 = bfhi(gt[e]) * (cw[c + 1] * bfhi(pp[e]) + cw[2048 + c + 1] * bfhi(pc[e]) + cw[4096 + c + 1] * bfhi(pn[e]) + cb[c + 1]);
            o[e] = pk2(y0, y1); }
        *(v4u*)(pg + (size_t)m * 4096 + 2048 + c0) = o;
    }
}
constexpr int N_PHASES = 13;
__global__ void __launch_bounds__(NTHR, 2) hybrid_fwd(Params p) {
    extern __shared__ __attribute__((aligned(16))) unsigned char lds_raw[];
    LAS unsigned char* lds = (LAS unsigned char*)lds_raw;
    const int tid = threadIdx.x, G = gridDim.x, bx = blockIdx.x;
    const int vcu = (G % 8 == 0) ? (bx % 8) * (G / 8) + bx / 8 : bx;
    volatile LAS unsigned* misc = (volatile LAS unsigned*)(lds + LDS_MISC);
    if (tid < 64) misc[tid] = 0u;
    __syncthreads();
    XcdBarrier bar = xcd_barrier_post((unsigned*)(p.ws + WS_CTL) + 1024, misc + 8);
    const int lo = p.ph_lo, hi = p.ph_hi;
#ifdef ONLY_PHASE
#define IN(k) ((k) == ONLY_PHASE && lo <= (k) && (k) < hi)
#else
#define IN(k) (lo <= (k) && (k) < hi)
#endif
#define SEAM(k) do { if (IN(k) && IN((k) + 1)) xcd_barrier(bar); } while (0)
    unsigned char* ws = p.ws; unsigned char* ob = (unsigned char*)p.out;
    const float* ada = (const float*)(ws + WS_ADA);

    if (IN(0)) { p0_prologue(p, lds, vcu, G); } SEAM(0);
    if (IN(1)) { weight_copies(p, lds, vcu, G); h_phase(p, 0, vcu, G); } SEAM(1);
    if (IN(2)) {
        pg8::Gemm g{(const bf16*)(ws + WS_H), (const bf16*)(ws + WS_WIN), NT, 4352, 1024, 1024}; pg8::StaticOrder S; S.init(NT, 4352, 1024, G, bx);
        Epi1a E{ws, ob};
        pg8::gemm_phase<Epi1a, pg8::StaticOrder, true, true>(lds, g, S, E);
    } SEAM(2);
    if (IN(3)) { scan_phase(p, lds, vcu, G); } SEAM(3);
    if (IN(4)) { scan_fixup_phase(p, vcu, G); } SEAM(4);
    if (IN(5)) { post_scan_phase(p, vcu, G); } SEAM(5);
    if (IN(6)) {
        pg8::Gemm g{(const bf16*)(ws + WS_H), (const bf16*)(ws + WS_WIN) + (size_t)4352 * 1024, NT, 4096, 1024, 1024}; pg8::StaticOrder S; S.init(NT, 4096, 1024, G, bx);
        LAS float* tab = (LAS float*)(lds + 131072);
        for (int i = tid; i < 2048 + 128; i += NTHR) tab[i] = (i < 2048) ? ((const float*)(ws + WS_ROPE))[i] : (i < 2112 ? p.in[I_QN][i - 2048] : p.in[I_KN][i - 2112]);
        __syncthreads();
        Epi1b E{(bf16*)(ws + X_Q), (bf16*)(ws + X_KP), (bf16*)(ob + O_VP), (bf16*)(ws + WS_YAB), (float*)(ob + O_NK), (float*)(ob + O_NV), tab};
        pg8::gemm_phase<Epi1b, pg8::StaticOrder, true, true>(lds, g, S, E);
        ctx_convert(p, vcu, G);
    } SEAM(6);
    if (IN(7)) { attn_phase(p, lds, vcu, G); } SEAM(7);
    if (IN(8)) {
        pg8::Gemm g{(const bf16*)(ws + WS_YAB), (const bf16*)(ws + WS_WOUT0), NT, 1024, 2048, 2048}; pg8::TailSplitOrder S; S.init(NT, 1024, 2048, G, bx);
        EpiRes E{p.in[I_XP], p.in[I_XS] - (size_t)NTP * 1024, p.out, ada,
            (float*)(ws + WS_X), (unsigned*)(ws + WS_CTL) + CW_SPLIT};
        pg8::gemm_phase<EpiRes, pg8::TailSplitOrder, true, true>(lds, g, S, E);
        if (S.split) { LAS float* scr = (LAS float*)(lds + 32768); __syncthreads(); for (int it = vcu; it < 128 * 16; it += G) conv_tile<2>(p.in[I_OWIN], 1024, 8192, (bf16*)(ws + WS_WIN), it, scr); }
        else { const int nsec = 320 - G; if (nsec >= 0 && nsec < G && bx >= nsec) { LAS float* scr = (LAS float*)(lds + 32768); __syncthreads();
            for (int it = bx - nsec; it < 128 * 16; it += G - nsec) conv_tile<2>(p.in[I_OWIN], 1024, 8192, (bf16*)(ws + WS_WIN), it, scr); }
          else if (!(nsec >= 0 && nsec < G)) { LAS float* scr = (LAS float*)(lds + 32768); __syncthreads(); for (int it = vcu; it < 128 * 16; it += G) conv_tile<2>(p.in[I_OWIN], 1024, 8192, (bf16*)(ws + WS_WIN), it, scr); } }
    } SEAM(8);
    if (IN(9)) {
        h_phase(p, 1, vcu, G);
    } SEAM(9);
    if (IN(10)) {
        pg8::Gemm g{(const bf16*)(ws + WS_H), (const bf16*)(ws + WS_WIN), NT, 8192, 1024, 1024}; pg8::StaticOrder S; S.init(NT, 8192, 1024, G, bx);
        EpiGateConv E{(bf16*)(ws + WS_YAB), (float*)(ws + WS_CSB), p.in[I_CONVW], p.in[I_CONVB], (LAS float*)(lds + 131072)};
        pg8::gemm_phase<EpiGateConv, pg8::StaticOrder, true, true>(lds, g, S, E);
    } SEAM(10);
    if (IN(11)) { conv_fix_phase(p, vcu, G); } SEAM(11);
    if (IN(12)) {
        pg8::Gemm g{(const bf16*)(ws + WS_YAB), (const bf16*)(ws + WS_WOUT1), NT, 1024, 2048, 2048}; pg8::TailSplitOrder S; S.init(NT, 1024, 2048, G, bx);
        EpiRes E{p.out, p.out, p.out, ada + 5 * 3072, (float*)(ws + WS_WIN), (unsigned*)(ws + WS_CTL) + CW_SPLIT + 2048};
        pg8::gemm_phase<EpiRes, pg8::TailSplitOrder, true, true>(lds, g, S, E);
    }
#undef IN
#undef SEAM
}

#ifndef MK_N_LAUNCHES
#define MK_N_LAUNCHES 1
#endif
extern "C" void kernel_launch(void* const* d_in, const int* in_sizes, int n_in, void* d_out, int out_size, void* d_ws, size_t ws_size, hipStream_t stream) {
    static int grid = 0;
    if (grid == 0) {
        int dev = 0, cus = 0;
        if (n_in != 31 || ws_size < 256 * MiB || hipGetDevice(&dev) != hipSuccess || hipDeviceGetAttribute(&cus, hipDeviceAttributeMultiprocessorCount, dev) != hipSuccess) { fprintf(stderr, "kernel_launch: unexpected arguments / device (n_in %d, ws %zu)\n", n_in, ws_size); grid = -1; return; }
        if (hipFuncSetAttribute((const void*)hybrid_fwd, hipFuncAttributeMaxDynamicSharedMemorySize, LDS_BYTES) != hipSuccess) { fprintf(stderr, "kernel_launch: hipFuncSetAttribute failed\n"); grid = -1; return; }
        int per_cu = 0;
        if (hipOccupancyMaxActiveBlocksPerMultiprocessor(&per_cu, (const void*)hybrid_fwd, NTHR, LDS_BYTES) != hipSuccess || per_cu < 1) fprintf(stderr, "kernel_launch: occupancy query reports %d blocks per CU\n", per_cu);
        (void)hipGetLastError();
        grid = cus;
    }
    if (grid < 0) return;
    Params p{};
    for (int i = 0; i < 31; ++i) p.in[i] = (const float*)d_in[i];
    p.out = (float*)d_out; p.ws = (unsigned char*)d_ws;
    (void)hipMemsetAsync((char*)d_ws + WS_CTL, 0, CTL_ZERO_BYTES, stream);
    if (MK_N_LAUNCHES == 1) {
        p.ph_lo = 0; p.ph_hi = N_PHASES;
        hipLaunchKernelGGL(hybrid_fwd, dim3(grid), dim3(NTHR), LDS_BYTES, stream, p);
    } else {
        for (int k = 0; k < N_PHASES; ++k) { p.ph_lo = k; p.ph_hi = k + 1;
            hipLaunchKernelGGL(hybrid_fwd, dim3(grid), dim3(NTHR), LDS_BYTES, stream, p);
        }
    }
    const hipError_t le = hipPeekAtLastError();
    if (le != hipSuccess) fprintf(stderr, "kernel_launch: launch failed: %s\n", hipGetErrorName(le));
}
```

```cpp
#include <hip/hip_runtime.h>
#include <cstdio>
#include <cstdint>
namespace pg8 {
#define PG8_LAS __attribute__((address_space(3)))
typedef unsigned short bf16_t;
typedef short bf16x8 __attribute__((ext_vector_type(8)));
typedef float f32x4 __attribute__((ext_vector_type(4)));
typedef unsigned u32x4 __attribute__((ext_vector_type(4)));
constexpr int BM = 256, BK = 64, HALF = 128, HTB = HALF * BK * 2  , STAGE_BYTES = 8 * HTB, NXCD = 8, WGM = 8;

__host__ __device__ __forceinline__ int lds_byte(int r, int c) { const int st = (r >> 4) * 2 + (c >> 5), rr = r & 15, cc = c & 31, ob = rr * 64 + cc * 2; return st * 1024 + (ob ^ (((ob >> 9) & 1) << 5)); }
__host__ __device__ __forceinline__ void stage_rc(int b, int& R, int& C) { const int st = b / 1024, sb = b % 1024, swz = sb ^ (((sb >> 9) & 1) << 5); R = (st >> 1) * 16 + swz / 64; C = (st & 1) * 32 + (swz % 64) / 2; }
__host__ __device__ __forceinline__ int perm32(int rho) { const int n = rho >> 4, i = rho & 15; return 8 * (i >> 2) + 4 * n + (i & 3); }

struct Unit { int pm, pn, k0, nt, part, tix; };
struct Gemm { const bf16_t* A; const bf16_t* Bt; int M, N, K, lda; };

struct StaticOrder {
    int nM, nN, nwg, G, c, ntk;
    __host__ __device__ void init(int M, int N, int K, int G_, int c_) { nM = M / BM; nN = N / BM; nwg = nM * nN; G = G_; c = c_; ntk = K / BK; }
    __host__ __device__ bool tile(long L, Unit& u) const {
        if (L >= nwg) return false;
        int wgid = (int)L; { const int q = nwg / NXCD, r = nwg % NXCD, xcd = wgid % NXCD, off = wgid / NXCD; wgid = (xcd < r ? xcd * (q + 1) : r * (q + 1) + (xcd - r) * q) + off; }
        const int nig = WGM * nN, gid = wgid / nig, fm = gid * WGM, gsz = (nM - fm) < WGM ? (nM - fm) : WGM;
        u.pm = fm + ((wgid % nig) % gsz); u.pn = (wgid % nig) / gsz; u.k0 = 0; u.nt = ntk; u.part = -1; u.tix = 0; return true;
    }
    __host__ __device__ bool next(int i, Unit& u) const { return tile((long)i * G + c, u); }
    __device__ __forceinline__ void a_ready(const Unit&) const {}
    __device__ __forceinline__ void done(const Unit&) const {}
};
struct TailSplitOrder {
    StaticOrder s; int split;
    __host__ __device__ void init(int M, int N, int K, int G_, int c_) { s.init(M, N, K, G_, c_); split = (s.nwg > G_ && 4 * (s.nwg - G_) == G_ && (s.ntk % 8) == 0) ? 1 : 0; }
    __host__ __device__ bool next(int i, Unit& u) const {
        if (!split || i == 0) return s.next(i, u);
        if (i > 1) return false;
        int j, t; if (s.G % 32 == 0) { const int x = s.c & 7, r = s.c >> 3; j = r & 3; t = (r >> 2) * 8 + x; } else { j = s.c & 3; t = s.c >> 2; }
        if (!s.tile((long)s.G + t, u)) return false;
        u.nt = s.ntk / 4; u.k0 = j * u.nt; u.part = j; u.tix = t; return true;
    }
    __device__ __forceinline__ void a_ready(const Unit&) const {}
    __device__ __forceinline__ void done(const Unit&) const {}
};


template <class Epi, class Sched, bool ALIGN_EPI = false, bool SP2 = false>
__device__ __forceinline__ void gemm_phase(PG8_LAS unsigned char* lds, const Gemm g, const Sched& S, const Epi& E) {
    const int tid = threadIdx.x, wid = __builtin_amdgcn_readfirstlane(tid >> 6), lane = tid & 63, wr = wid >> 2, wc = wid & 3, fr = lane & 15, fq = lane >> 4;
    const int K = g.K;
    unsigned voffA[2], voffB[2];
#pragma unroll
    for (int i = 0; i < 2; ++i) { int R, C; stage_rc(tid * 16 + i * 8192, R, C); const int Rb = Epi::PERM ? ((R & ~31) + perm32(R & 31)) : R;
        voffA[i] = (unsigned)(R * g.lda + C) * 2u; voffB[i] = (unsigned)(Rb * K + C) * 2u; }
    const size_t kstep = (size_t)(BK * 2);
    const size_t hstep = (size_t)HALF * K * 2;
    const size_t hstepA = (size_t)HALF * g.lda * 2, tstepA = 2 * hstepA;
    const size_t tstep = 2 * hstep;
    const unsigned ldsw = (unsigned)wid * 1024u;
    const int aoff = lds_byte(wr * 64 + fr, fq * 8), boff = lds_byte(wc * 32 + fr, fq * 8);
#define PG8_SA(b, h) (((b) * 2 + (h)) * HTB)
#define PG8_SB(b, h) ((4 + (b) * 2 + (h)) * HTB)
#define PG8_STAGE(bufoff, gbase, voff) do { _Pragma("unroll") for (int _i = 0; _i < 2; ++_i) \
        __builtin_amdgcn_global_load_lds((const unsigned*)((const char*)(gbase) + (voff)[_i]), (PG8_LAS unsigned*)(lds + (bufoff) + ldsw + _i * 8192), 16, 0, 0); } while (0)
#define PG8_LDA(dst, b, h) do { _Pragma("unroll") for (int m = 0; m < 4; ++m) _Pragma("unroll") for (int k = 0; k < 2; ++k) dst[m][k] = *(const PG8_LAS bf16x8*)(lds + PG8_SA(b, h) + aoff + m * 2048 + k * 1024); } while (0)
#define PG8_LDB(dst, b, h) do { _Pragma("unroll") for (int n = 0; n < 2; ++n) _Pragma("unroll") for (int k = 0; k < 2; ++k) dst[n][k] = *(const PG8_LAS bf16x8*)(lds + PG8_SB(b, h) + boff + n * 2048 + k * 1024); } while (0)
#define PG8_MMA(ai, bj, At, Bt) do { __builtin_amdgcn_s_setprio(1); _Pragma("unroll") for (int m = 0; m < 4; ++m) _Pragma("unroll") for (int n = 0; n < 2; ++n) _Pragma("unroll") for (int k = 0; k < 2; ++k) \
        acc[ai][bj][m][n] = __builtin_amdgcn_mfma_f32_16x16x32_bf16(Bt[n][k], At[m][k], acc[ai][bj][m][n], 0, 0, 0); __builtin_amdgcn_s_setprio(0); } while (0)
#define PG8_WAIT_V(n) asm volatile("s_waitcnt vmcnt(" #n ")" ::: "memory")
#define PG8_WAIT_L(n) asm volatile("s_waitcnt lgkmcnt(" #n ")" ::: "memory")
#define PG8_BAR __builtin_amdgcn_s_barrier()
#define PG8_SCHED __builtin_amdgcn_sched_barrier(0)
    Unit cur, nxt; int ui = 0;
    if (!S.next(0, cur)) return;
    f32x4 acc[2][2][4][2];
#pragma unroll
    for (int a = 0; a < 2; ++a)
#pragma unroll
        for (int b = 0; b < 2; ++b)
#pragma unroll
            for (int m = 0; m < 4; ++m)
#pragma unroll
                for (int n = 0; n < 2; ++n) acc[a][b][m][n] = (f32x4){0.f, 0.f, 0.f, 0.f};
    bf16x8 At[4][2], B0[2][2], B1[2][2];
    const char* cA = (const char*)g.A + (size_t)cur.pm * tstepA + (size_t)cur.k0 * kstep; const char* cB = (const char*)g.Bt + (size_t)cur.pn * tstep + (size_t)cur.k0 * kstep;
    S.a_ready(cur);
    if constexpr (SP2) {
        PG8_STAGE(PG8_SB(0, 0), cB, voffB); PG8_STAGE(PG8_SB(0, 1), cB + hstep, voffB); PG8_STAGE(PG8_SA(0, 0), cA, voffA); PG8_STAGE(PG8_SA(0, 1), cA + hstepA, voffA);
        if (wr == 1) PG8_BAR;
        PG8_WAIT_V(2); PG8_BAR;
        PG8_STAGE(PG8_SB(1, 0), cB + kstep, voffB); PG8_STAGE(PG8_SA(1, 0), cA + kstep, voffA); PG8_STAGE(PG8_SB(1, 1), cB + hstep + kstep, voffB);
        PG8_WAIT_V(6); PG8_BAR;
    } else {
        PG8_STAGE(PG8_SB(0, 0), cB, voffB); PG8_STAGE(PG8_SA(0, 0), cA, voffA); PG8_STAGE(PG8_SB(0, 1), cB + hstep, voffB); PG8_STAGE(PG8_SA(0, 1), cA + hstepA, voffA);
        if (wr == 1) PG8_BAR;
        PG8_WAIT_V(4); PG8_BAR;
        PG8_STAGE(PG8_SB(1, 0), cB + kstep, voffB); PG8_STAGE(PG8_SA(1, 0), cA + kstep, voffA); PG8_STAGE(PG8_SB(1, 1), cB + hstep + kstep, voffB);
        PG8_WAIT_V(6); PG8_BAR;
    }
    for (;;) {
        const bool has_next = S.next(ui + 1, nxt);
        const char* nA = has_next ? (const char*)g.A + (size_t)nxt.pm * tstepA + (size_t)nxt.k0 * kstep : cA; const char* nB = has_next ? (const char*)g.Bt + (size_t)nxt.pn * tstep + (size_t)nxt.k0 * kstep : cB;
        const int nt = cur.nt;
        for (int t = 0; t < nt; t += 2) {
            const bool last = (t == nt - 2);
            const char* a1 = cA + (size_t)(t + 1) * kstep;
            const char* a2 = last ? nA : cA + (size_t)(t + 2) * kstep; const char* b2 = last ? nB : cB + (size_t)(t + 2) * kstep;
            const char* a3 = a2 + kstep; const char* b3 = b2 + kstep;
            if (last && has_next) S.a_ready(nxt);
            if constexpr (SP2) {
            PG8_LDB(B0, 0, 0); PG8_LDB(B1, 0, 1); PG8_SCHED; PG8_LDA(At, 0, 0); PG8_STAGE(PG8_SA(1, 1), a1 + hstepA, voffA);
            PG8_WAIT_V(8); PG8_WAIT_L(0); PG8_BAR; PG8_MMA(0, 0, At, B0); PG8_MMA(0, 1, At, B1); PG8_BAR; PG8_SCHED;
            PG8_LDA(At, 0, 1); PG8_STAGE(PG8_SB(0, 0), b2, voffB); PG8_STAGE(PG8_SB(0, 1), b2 + hstep, voffB); PG8_STAGE(PG8_SA(0, 0), a2, voffA);
            PG8_WAIT_V(8); PG8_WAIT_L(0); PG8_BAR; PG8_MMA(1, 0, At, B0); PG8_MMA(1, 1, At, B1); PG8_BAR; PG8_SCHED;
            PG8_LDB(B0, 1, 0); PG8_LDB(B1, 1, 1); PG8_SCHED; PG8_LDA(At, 1, 0); PG8_STAGE(PG8_SA(0, 1), a2 + hstepA, voffA);
            PG8_WAIT_V(8); PG8_WAIT_L(0); PG8_BAR; PG8_MMA(0, 0, At, B0); PG8_MMA(0, 1, At, B1); PG8_BAR; PG8_SCHED;
            PG8_LDA(At, 1, 1); PG8_STAGE(PG8_SB(1, 0), b3, voffB); PG8_STAGE(PG8_SB(1, 1), b3 + hstep, voffB); PG8_STAGE(PG8_SA(1, 0), a3, voffA);
            PG8_WAIT_V(8); PG8_WAIT_L(0); PG8_BAR; PG8_MMA(1, 0, At, B0); PG8_MMA(1, 1, At, B1); PG8_BAR; PG8_SCHED;
            } else {
            PG8_LDB(B0, 0, 0); PG8_SCHED; PG8_LDA(At, 0, 0); PG8_STAGE(PG8_SA(1, 1), a1 + hstepA, voffA);
            PG8_WAIT_L(8); PG8_BAR; PG8_WAIT_L(0); PG8_MMA(0, 0, At, B0); PG8_BAR; PG8_SCHED;
            PG8_LDB(B1, 0, 1); PG8_STAGE(PG8_SB(0, 0), b2, voffB);
            PG8_BAR; PG8_WAIT_L(0); PG8_MMA(0, 1, At, B1); PG8_BAR;
            PG8_LDA(At, 0, 1); PG8_STAGE(PG8_SA(0, 0), a2, voffA);
            PG8_BAR; PG8_WAIT_L(0); PG8_MMA(1, 0, At, B0); PG8_BAR; PG8_SCHED;
            PG8_STAGE(PG8_SB(0, 1), b2 + hstep, voffB);
            PG8_WAIT_V(6); PG8_BAR; PG8_MMA(1, 1, At, B1); PG8_BAR;
            PG8_LDB(B0, 1, 0); PG8_SCHED; PG8_LDA(At, 1, 0); PG8_STAGE(PG8_SA(0, 1), a2 + hstepA, voffA);
            PG8_WAIT_L(8); PG8_BAR; PG8_WAIT_L(0); PG8_MMA(0, 0, At, B0); PG8_BAR; PG8_SCHED;
            PG8_LDB(B1, 1, 1); PG8_STAGE(PG8_SB(1, 0), b3, voffB);
            PG8_BAR; PG8_WAIT_L(0); PG8_MMA(0, 1, At, B1); PG8_BAR;
            PG8_LDA(At, 1, 1); PG8_STAGE(PG8_SA(1, 0), a3, voffA);
            PG8_BAR; PG8_WAIT_L(0); PG8_MMA(1, 0, At, B0); PG8_BAR; PG8_SCHED;
            PG8_STAGE(PG8_SB(1, 1), b3 + hstep, voffB);
            PG8_WAIT_V(6); PG8_BAR; PG8_MMA(1, 1, At, B1); PG8_BAR;
            }
        }
        if constexpr (ALIGN_EPI) { if (wr == 0) PG8_BAR; }
        if constexpr (!Epi::AFTER_DRAIN) { E(acc, cur, wr, wc, fr, fq); S.done(cur); }
        if (!has_next) break;
#pragma unroll
        for (int a = 0; a < 2; ++a)
#pragma unroll
            for (int b = 0; b < 2; ++b)
#pragma unroll
                for (int m = 0; m < 4; ++m)
#pragma unroll
                    for (int n = 0; n < 2; ++n) acc[a][b][m][n] = (f32x4){0.f, 0.f, 0.f, 0.f};
        cur = nxt; cA = nA; cB = nB; ++ui;
        if constexpr (ALIGN_EPI) { if (wr == 1) PG8_BAR; }
    }
    PG8_WAIT_V(0);
    if constexpr (!ALIGN_EPI) { if (wr == 0) PG8_BAR; }
    PG8_BAR;
    if constexpr (Epi::AFTER_DRAIN) { E.fused(acc, cur, wr, wc, fr, fq, lds, wid, lane); S.done(cur); }
#undef PG8_SA
#undef PG8_SB
#undef PG8_STAGE
#undef PG8_LDA
#undef PG8_LDB
#undef PG8_MMA
#undef PG8_WAIT_V
#undef PG8_WAIT_L
#undef PG8_BAR
#undef PG8_SCHED
}
}
#define GAS __attribute__((address_space(1)))
#define LAS __attribute__((address_space(3)))
typedef unsigned short bf16;
typedef unsigned v4u __attribute__((ext_vector_type(4)));
typedef unsigned v2u __attribute__((ext_vector_type(2)));
typedef float f32x4 __attribute__((ext_vector_type(4)));
typedef float f32x16 __attribute__((ext_vector_type(16)));
typedef short bf16x8 __attribute__((ext_vector_type(8)));
typedef short s16x4 __attribute__((ext_vector_type(4)));
typedef _Float16 h8 __attribute__((ext_vector_type(8)));

constexpr int NWAVES = 8, NTHR = 512;
constexpr int D = 1024, NTP = 4096, NTS = 16384, NT = 20480;
constexpr int TP = 256, TS = 4096, TKS = 4352;
constexpr size_t MiB = 1u << 20;
constexpr size_t WS_CTL = 0, CTL_ZERO_BYTES = 65536;
constexpr int CW_SPLIT = 8192;
constexpr size_t WS_ADA = 65536;
constexpr size_t WS_ROPE = 196608;
constexpr size_t WS_KMAX = 204800;
constexpr size_t WS_WUPT = 262144;
constexpr size_t WS_BN = 786432;
constexpr size_t WS_WOUT1 = 4 * MiB;
constexpr size_t WS_WIN = 8 * MiB;
constexpr size_t WS_WOUT0 = 25 * MiB;
constexpr size_t WS_H = 29 * MiB;
constexpr size_t WS_YAB = 69 * MiB;
constexpr size_t WS_X = 149 * MiB;
constexpr size_t WS_X1B = WS_X + 24 * MiB;
constexpr size_t WS_CSB = WS_X + 64 * MiB;
constexpr size_t X_PAR = WS_X, X_PAK = WS_X + 40 * MiB, X_PAL = WS_X + 80 * MiB, X_OFP = WS_X + 90 * MiB, X_SMID = WS_X + 98 * MiB;
constexpr size_t X_Q = WS_X, X_KP = WS_X + 40 * MiB, X_KS = WS_X + 48 * MiB;
constexpr size_t WS_PG = WS_YAB;
static_assert(WS_BN + (size_t)NT * 32 * 4 <= WS_WOUT1 && WS_WIN + (size_t)8448 * 1024 * 2 <= WS_WOUT0 && X_OFP + 8 * MiB <= 256 * MiB && X_KS + 34 * MiB <= 256 * MiB && WS_PG + 160 * MiB <= 256 * MiB, "ws map");
constexpr size_t O_Y = 0, O_SF = 80 * MiB, O_SB = 84 * MiB, O_NK = 88 * MiB, O_NV = 104 * MiB;
constexpr size_t O_PAV = 0, O_OB = 40 * MiB, O_OFS = 88 * MiB;
constexpr size_t O_VP = 0, O_VS = 8 * MiB;
constexpr int LDS_BYTES = 147456, LDS_MISC = 147200;

__device__ __forceinline__ unsigned f2bf(float f) { unsigned u = __builtin_bit_cast(unsigned, f); return (u + 0x7fffu + ((u >> 16) & 1u)) >> 16; }
__device__ __forceinline__ unsigned pk2(float lo, float hi) { return f2bf(lo) | (f2bf(hi) << 16); }
__device__ __forceinline__ float bf2f(unsigned h) { return __builtin_bit_cast(float, h << 16); }
__device__ __forceinline__ float bflo(unsigned w) { return __builtin_bit_cast(float, w << 16); }
__device__ __forceinline__ float bfhi(unsigned w) { return __builtin_bit_cast(float, w & 0xffff0000u); }
__device__ __forceinline__ float frcp(float x) { return __builtin_amdgcn_rcpf(x); }
__device__ __forceinline__ float siluf(float x) { return x * frcp(1.f + __expf(-x)); }
__device__ __forceinline__ float sigmf(float x) { return frcp(1.f + __expf(-x)); }
__device__ __forceinline__ float wave_sum(float v) {
#pragma unroll
    for (int o = 1; o < 64; o <<= 1) v += __shfl_xor(v, o);
    return v;
}
__device__ __forceinline__ float wave_max(float v) {
#pragma unroll
    for (int o = 1; o < 64; o <<= 1) v = fmaxf(v, __shfl_xor(v, o));
    return v;
}
template <int CTRL> __device__ __forceinline__ float dppf(float x) { return __builtin_bit_cast(float, __builtin_amdgcn_update_dpp(0, __builtin_bit_cast(int, x), CTRL, 0xf, 0xf, true)); }
__device__ __forceinline__ float sum8(float x) { x += dppf<0xB1>(x); x += dppf<0x4E>(x); x += dppf<0x141>(x); return x; }
__device__ __forceinline__ float sum16(float x) { x = sum8(x); x += dppf<0x140>(x); return x; }

__device__ __forceinline__ void glds16(const void* gsrc, unsigned lds_dst) { unsigned keep;
    asm volatile("s_mov_b32 %0, m0\n\ts_mov_b32 m0, %2\n\ts_nop 0\n\tglobal_load_lds_dwordx4 %1, off\n\ts_mov_b32 m0, %0" : "=&s"(keep) : "v"(gsrc), "s"(lds_dst) : "memory"); }

struct Params {
    const float* in[31];
    float* out;
    unsigned char* ws;
    int ph_lo, ph_hi;
};
enum { I_XP = 0, I_XS, I_SF, I_SB, I_CK, I_CV, I_C, I_CCTX, I_NW, I_ADAW, I_ADAB, I_EWIN, I_EWOUT, I_MU, I_W0, I_WUP, I_A0, I_AUP, I_KK, I_KA, I_RK, I_LNW, I_LNB,
       I_QN, I_KN, I_LAM, I_SUBLN, I_OWIN, I_CONVW, I_CONVB, I_OWOUT };
#define XB_TMO      128
#define XB_XCNT(j)  (256  + 64 * (j))
#define XB_XSUB(j)  (1280 + 64 * (j))
#define XB_XGEN(j)  (2304 + 64 * (j))
#define XB_TOP      3328
#define XB_TOPGEN   3392
#define XCD_BAR_WORDS 3456
#define XB_SPIN_CAP (1u << 18)

__device__ __forceinline__ unsigned xb_ld(unsigned* p)              { return __hip_atomic_load(p, __ATOMIC_RELAXED, __HIP_MEMORY_SCOPE_AGENT); }
__device__ __forceinline__ unsigned xb_add(unsigned* p, unsigned v) { return __hip_atomic_fetch_add(p, v, __ATOMIC_RELAXED, __HIP_MEMORY_SCOPE_AGENT); }
__device__ __forceinline__ unsigned xb_xcc_id() { return (unsigned)__builtin_amdgcn_s_getreg((3 << 11) | 20) & 0xFu; }
#define XB_SPIN(cond, bar) do { unsigned _sp = 0; while (cond) { __builtin_amdgcn_s_sleep(1); \
    if ((++_sp & 255u) == 0u) { if (xb_ld(&(bar)[XB_TMO])) break; if (_sp > XB_SPIN_CAP) { atomicAdd(&(bar)[XB_TMO], 1u); break; } } } } while (0)

struct XcdBarrier {
    unsigned* bar; unsigned x;
    volatile LAS unsigned* st;
};

__device__ __forceinline__ XcdBarrier xcd_barrier_post(unsigned* bar, volatile LAS unsigned* st) {
    XcdBarrier b; b.bar = bar; b.x = xb_xcc_id(); b.st = st;
    if (threadIdx.x == 0) (void)xb_add(&bar[XB_XCNT(b.x)], 1u);
    return b;
}
__device__ __forceinline__ void xcd_barrier_complete(unsigned* bar, unsigned x, unsigned& nloc, unsigned& nx) {
    const unsigned G = gridDim.x * gridDim.y * gridDim.z;
    unsigned sum, cnt, mine, sp = 0u;
    for (;;) {
        sum = 0u; cnt = 0u; mine = 0u;
#pragma unroll
        for (unsigned j = 0; j < 16; ++j) { const unsigned c = xb_ld(&bar[XB_XCNT(j)]); sum += c; cnt += (c > 0u) ? 1u : 0u; mine = (j == x) ? c : mine; }
        if (sum == G) break;
        __builtin_amdgcn_s_sleep(1);
        if ((++sp & 255u) == 0u) { if (xb_ld(&bar[XB_TMO])) break; if (sp > XB_SPIN_CAP) { atomicAdd(&bar[XB_TMO], 1u); break; } }
    }
    nloc = mine > 0u ? mine : 1u; nx = cnt > 0u ? cnt : 1u;
}

__device__ __forceinline__ void xcd_barrier(const XcdBarrier& b) {
    asm volatile("s_waitcnt vmcnt(0)" ::: "memory");
    __syncthreads();
    if (threadIdx.x == 0) {
        unsigned* bar = b.bar;
        __builtin_amdgcn_s_waitcnt(0);
        unsigned nloc = b.st[0], nx = b.st[1];
        if (nloc == 0u) { xcd_barrier_complete(bar, b.x, nloc, nx); b.st[0] = nloc; b.st[1] = nx; }
        const unsigned old = xb_add(&bar[XB_XSUB(b.x)], 1u);
        const unsigned gen = old / nloc;
        if (old + 1u == (gen + 1u) * nloc) {
            __builtin_amdgcn_fence(__ATOMIC_RELEASE, "agent");
            asm volatile("s_waitcnt vmcnt(0)" ::: "memory");
            const unsigned og = xb_add(&bar[XB_TOP], 1u);
            const unsigned tg = og / nx;
            if (og + 1u == (tg + 1u) * nx) xb_add(&bar[XB_TOPGEN], 1u);
            else XB_SPIN(xb_ld(&bar[XB_TOPGEN]) == tg, bar);
            __builtin_amdgcn_fence(__ATOMIC_ACQUIRE, "agent");
            xb_add(&bar[XB_XGEN(b.x)], 1u);
            asm volatile("s_waitcnt vmcnt(0)" ::: "memory");
        } else {
            XB_SPIN(xb_ld(&bar[XB_XGEN(b.x)]) == gen, bar);
            __builtin_amdgcn_fence(__ATOMIC_ACQUIRE, "agent");
            asm volatile("s_waitcnt vmcnt(0)" ::: "memory");
        }
    }
    __syncthreads();
}

__device__ __forceinline__ int perm32d(int rho) { const int n = rho >> 4, i = rho & 15; return 8 * (i >> 2) + 4 * n + (i & 3); }
template <int MAP> __device__ __forceinline__ int srccol(int np) {
    if (MAP == 0) return np;
    if (MAP == 1) {
        if (np < 4352) return (np & ~31) + perm32d(np & 31);
        const int m = np - 4352, tile = m >> 8, rho = m & 255;
        if (tile < 8) { const int bj = rho >> 7, wc = (rho >> 5) & 3, r32 = rho & 31; return 4352 + tile * 256 + 64 * wc + 32 * bj + r32; }
        return 4352 + (m & ~31) + perm32d(m & 31);
    }
    { const int T = np >> 8, rho = np & 255, bj = rho >> 7, wc = (rho >> 5) & 3, n = (rho >> 4) & 1, i = rho & 15; return (2 * bj + n) * 2048 + 64 * T + 16 * wc + i; }
}
template <int MAP> __device__ __forceinline__ void conv_tile(const float* src, int K, int N, bf16* dst, int tile, LAS float* scr) {
    const int tid = threadIdx.x, nkt = K / 64, nt = tile / nkt, kt = tile % nkt, n0 = nt * 64, k0 = kt * 64;
    { const int nn = tid & 63, kq = tid >> 6; const int sc = srccol<MAP>(n0 + nn);
#pragma unroll
      for (int i = 0; i < 8; ++i) { const int kk = kq + 8 * i; scr[kk * 65 + nn] = src[(size_t)(k0 + kk) * N + sc]; } }
    __syncthreads();
    { const int nn = tid >> 3, kc = tid & 7; const LAS float* s = scr + (8 * kc) * 65 + nn;
      v4u o; o.x = pk2(s[0], s[65]); o.y = pk2(s[2 * 65], s[3 * 65]); o.z = pk2(s[4 * 65], s[5 * 65]); o.w = pk2(s[6 * 65], s[7 * 65]);
      *(v4u*)(dst + (size_t)(n0 + nn) * K + k0 + 8 * kc) = o; }
    __syncthreads();
}
__device__ __forceinline__ void ada_item(const Params& p, int item, const LAS float* sc, LAS float* red) {
    const int tid = threadIdx.x, L = item / 96, col0 = (item % 96) * 32, cl = tid & 31, kg = tid >> 5;
    const float* w = p.in[I_ADAW] + ((size_t)L * 1024 + kg * 64) * 3072 + col0 + cl;
    float a0 = 0.f, a1 = 0.f, a2 = 0.f, a3 = 0.f, a4 = 0.f;
#pragma unroll 8
    for (int kk = 0; kk < 64; ++kk) { const float wv = w[(size_t)kk * 3072]; const int k = kg * 64 + kk;
        a0 += sc[k] * wv; a1 += sc[1024 + k] * wv; a2 += sc[2048 + k] * wv; a3 += sc[3072 + k] * wv; a4 += sc[4096 + k] * wv; }
    red[(kg * 5 + 0) * 32 + cl] = a0; red[(kg * 5 + 1) * 32 + cl] = a1; red[(kg * 5 + 2) * 32 + cl] = a2; red[(kg * 5 + 3) * 32 + cl] = a3; red[(kg * 5 + 4) * 32 + cl] = a4;
    __syncthreads();
    if (tid < 160) { const int v = tid >> 5; float s = p.in[I_ADAB][L * 3072 + col0 + cl];
#pragma unroll
        for (int g = 0; g < 16; ++g) s += red[(g * 5 + v) * 32 + cl];
        ((float*)(p.ws + WS_ADA))[(L * 5 + v) * 3072 + col0 + cl] = s; }
    __syncthreads();
}
__device__ __forceinline__ void p0_prologue(const Params& p, LAS unsigned char* lds, int vcu, int G) {
    const int tid = threadIdx.x, lane = tid & 63, wid = tid >> 6;
    LAS float* sc = (LAS float*)lds;
    LAS float* red = (LAS float*)(lds + 20480);
    LAS float* scr = (LAS float*)(lds + 32768);
    constexpr int N_ADA = 192, N_UP = 64, N_ROPE = 1, N_KMAX = 8;
    constexpr int NITEMS = N_ADA + N_UP + N_ROPE + N_KMAX;
    if (vcu < N_ADA) {
        for (int i = tid; i < 5 * 1024; i += NTHR) { const int v = i >> 10, k = i & 1023; const float x = (v == 0) ? p.in[I_CCTX][k] : p.in[I_C][(v - 1) * 1024 + k]; sc[i] = siluf(x); }
        __syncthreads();
    }
    for (int it = vcu; it < NITEMS; it += G) {
        int r = it;
        if (r < N_ADA) { ada_item(p, r, sc, red); continue; } r -= N_ADA;
        if (r < N_UP) { const int md = r >> 4, tl = r & 15;
            const float* src = ((md >> 1) ? p.in[I_AUP] : p.in[I_WUP]) + (size_t)(md & 1) * 64 * 1024;
            conv_tile<0>(src, 64, 1024, (bf16*)(p.ws + WS_WUPT) + (size_t)md * 65536, tl, scr); continue; } r -= N_UP;
        if (r < N_ROPE) { float* rt = (float*)(p.ws + WS_ROPE);
            for (int i = tid; i < 1024; i += NTHR) { const int pos = i >> 4, f = i & 15; const float inv = powf(10000.f, -(float)f / 16.f); const float ang = (float)pos * inv; rt[pos * 32 + f] = cosf(ang); rt[pos * 32 + 16 + f] = sinf(ang); }
            continue; } r -= N_ROPE;
        { const int gi = r * 8 + wid, b = gi >> 4, hc = gi & 15;
          float mx = 0.f;
          for (int q = 0; q < 4; ++q) { const int t = lane + 64 * q; const f32x4* kp = (const f32x4*)(p.in[I_CK] + ((size_t)(b * 256 + t) * 16 + hc) * 64); float ss = 0.f;
#pragma unroll
              for (int j = 0; j < 16; ++j) { const f32x4 v = kp[j]; ss += v.x * v.x + v.y * v.y + v.z * v.z + v.w * v.w; }
              mx = fmaxf(mx, ss); }
          mx = wave_max(mx);
          if (lane == 0) ((float*)(p.ws + WS_KMAX))[gi] = mx; }
    }
}
__device__ __forceinline__ void weight_copies(const Params& p, LAS unsigned char* lds, int vcu, int G) {
    LAS float* scr = (LAS float*)(lds + 32768);
    constexpr int N_EIN = 132 * 16, N_EOUT = 16 * 32, N_OOUT = 16 * 32;
    for (int it = vcu; it < N_EIN + N_EOUT + N_OOUT; it += G) {
        int r = it;
        if (r < N_EIN) { conv_tile<1>(p.in[I_EWIN], 1024, 8448, (bf16*)(p.ws + WS_WIN), r, scr); continue; } r -= N_EIN;
        if (r < N_EOUT) { conv_tile<0>(p.in[I_EWOUT], 2048, 1024, (bf16*)(p.ws + WS_WOUT0), r, scr); continue; } r -= N_EOUT;
        conv_tile<0>(p.in[I_OWOUT], 2048, 1024, (bf16*)(p.ws + WS_WOUT1), r, scr);
    }
}
__device__ __forceinline__ void h_phase(const Params& p, int L, int vcu, int G) {
    const int lane = threadIdx.x & 63, wid = threadIdx.x >> 6, gw = vcu * NWAVES + wid, NGW = G * NWAVES;
    const float* nw = p.in[I_NW] + L * 1024;
    bf16* H = (bf16*)(p.ws + WS_H);
    const int per = (NT + NGW - 1) / NGW, mlo = gw * per, mhi = (mlo + per < NT) ? mlo + per : NT;
    f32x4 fa[4], fb[4]; int cur = -1;
    for (int m = mlo; m < mhi; ++m) {
        const int vec = (m < NTP) ? 0 : 1 + ((m - NTP) >> 12);
        if (vec != cur) { cur = vec; const float* ada = (const float*)(p.ws + WS_ADA) + (size_t)(L * 5 + vec) * 3072;
#pragma unroll
            for (int j = 0; j < 4; ++j) { const int c = 4 * lane + 256 * j; fa[j] = *(const f32x4*)(nw + c) * (*(const f32x4*)(ada + 1024 + c) + 1.f); fb[j] = *(const f32x4*)(ada + c); } }
        const float* xrow = (m < NTP) ? p.in[I_XP] + (size_t)m * 1024 : p.in[I_XS] + (size_t)(m - NTP) * 1024;
        const bf16* xbrow = (const bf16*)(p.ws + WS_X1B) + (size_t)m * 1024;
        f32x4 v[4]; float ss = 0.f;
#pragma unroll
        for (int j = 0; j < 4; ++j) {
            if (L == 0) v[j] = *(const f32x4*)(xrow + 4 * lane + 256 * j);
            else { const v2u w = *(const v2u*)(xbrow + 4 * lane + 256 * j); v[j] = (f32x4){bflo(w.x), bfhi(w.x), bflo(w.y), bfhi(w.y)}; }
            ss += v[j].x * v[j].x + v[j].y * v[j].y + v[j].z * v[j].z + v[j].w * v[j].w; }
        const float rstd = rsqrtf(wave_sum(ss) * (1.f / 1024.f) + 1e-6f);
#pragma unroll
        for (int j = 0; j < 4; ++j) { const int c = 4 * lane + 256 * j;
            const f32x4 h = v[j] * rstd * fa[j] + fb[j];
            v2u o; o.x = pk2(h.x, h.y); o.y = pk2(h.z, h.w);
            *(v2u*)(H + (size_t)m * 1024 + c) = o; }
    }
}
__device__ __forceinline__ f32x4 silu4(f32x4 v) { return (f32x4){siluf(v.x), siluf(v.y), siluf(v.z), siluf(v.w)}; }
__device__ __forceinline__ size_t kvrow(int m) { return (m < NTP) ? (size_t)m : (size_t)NTP + (size_t)((m - NTP) >> 12) * TKS + ((m - NTP) & 4095); }

struct Epi1a {
    static constexpr bool PERM = false, AFTER_DRAIN = false;
    unsigned char *ws, *ob;
    __device__ __forceinline__ void operator()(const pg8::f32x4 (&acc)[2][2][4][2], const pg8::Unit& u, int wr_, int wc_, int fr_, int fq_) const {
        int fr = fr_, fq = fq_, wr = wr_, wc = wc_; asm volatile("" : "+v"(fr), "+v"(fq), "+v"(wr), "+v"(wc));
        const int pn = u.pn; unsigned char* base; unsigned boff; int pitch, colt; bool act = false;
        if (pn < 4) { base = ws; boff = (unsigned)X_PAR; pitch = 1024; colt = pn * 256; }
        else if (pn < 8) { base = ws; boff = (unsigned)X_PAK; pitch = 1024; colt = (pn - 4) * 256; }
        else if (pn < 12) { base = ob; boff = (unsigned)O_PAV; pitch = 1024; colt = (pn - 8) * 256; }
        else if (pn == 12) { base = ws; boff = (unsigned)X_PAL; pitch = 256; colt = 0; }
        else { base = ws; boff = (unsigned)WS_YAB; pitch = 2048; colt = (pn - 13) * 256; act = true; }
        const int row0 = u.pm * 256 + wr * 64 + fr, col0 = colt + wc * 32 + 8 * fq;
#pragma unroll
        for (int ai = 0; ai < 2; ++ai)
#pragma unroll
            for (int m = 0; m < 4; ++m) { const unsigned off = boff + ((unsigned)(row0 + ai * 128 + m * 16) * (unsigned)pitch + (unsigned)col0) * 2u;
#pragma unroll
                for (int bj = 0; bj < 2; ++bj) { f32x4 v0 = acc[ai][bj][m][0], v1 = acc[ai][bj][m][1];
                    if (act) { v0 = silu4(v0); v1 = silu4(v1); }
                    v4u w; w.x = pk2(v0[0], v0[1]); w.y = pk2(v0[2], v0[3]); w.z = pk2(v1[0], v1[1]); w.w = pk2(v1[2], v1[3]);
                    *(v4u*)(base + off + bj * 256) = w; } }
    }
};

constexpr float C2 = 0.125f * 1.4426950408889634f;
struct Epi1b {
    static constexpr bool PERM = false, AFTER_DRAIN = false;
    bf16 *q, *kbuf, *vbuf, *yab; float *nk, *nv; const LAS float* tab;
    __device__ __forceinline__ void operator()(const pg8::f32x4 (&acc)[2][2][4][2], const pg8::Unit& u, int wr_, int wc_, int fr_, int fq_) const {
        int fr = fr_, fq = fq_, wr = wr_, wc = wc_; asm volatile("" : "+v"(fr), "+v"(fq), "+v"(wr), "+v"(wc));
        const int pn = u.pn; const int row0 = u.pm * 256 + wr * 64 + fr; const bool prompt = (u.pm < 16);
        if (pn < 8) {
            const bool isq = pn < 4; const int colt = (pn & 3) * 256 + 64 * wc;
            const LAS float* nwp = tab + (isq ? 2048 : 2112);
#pragma unroll
            for (int ai = 0; ai < 2; ++ai)
#pragma unroll
                for (int m = 0; m < 4; ++m) { const int row = row0 + ai * 128 + m * 16;
                    f32x4 x[2][2]; float ss = 0.f;
#pragma unroll
                    for (int bj = 0; bj < 2; ++bj)
#pragma unroll
                        for (int n = 0; n < 2; ++n) { x[bj][n] = acc[ai][bj][m][n]; ss += x[bj][n][0] * x[bj][n][0] + x[bj][n][1] * x[bj][n][1] + x[bj][n][2] * x[bj][n][2] + x[bj][n][3] * x[bj][n][3]; }
                    ss += __shfl_xor(ss, 16); ss += __shfl_xor(ss, 32);
                    const float rstd = rsqrtf(ss * (1.f / 64.f) + 1e-6f);
#pragma unroll
                    for (int bj = 0; bj < 2; ++bj)
#pragma unroll
                        for (int n = 0; n < 2; ++n) x[bj][n] = x[bj][n] * rstd * *(const LAS f32x4*)(nwp + 32 * bj + 16 * n + 4 * fq);
                    if (!isq && prompt) {
                        float* o = nk + (size_t)row * 1024 + colt + 4 * fq;
#pragma unroll
                        for (int bj = 0; bj < 2; ++bj)
#pragma unroll
                            for (int n = 0; n < 2; ++n) *(f32x4*)(o + 32 * bj + 16 * n) = x[bj][n];
                    }
                    if (!prompt) {
                        const int t = (row - NTP) & 4095;
#pragma unroll
                        for (int bj = 0; bj < 2; ++bj) { const int pos = bj ? (t & 63) : (t >> 6);
                            const LAS float* rp = tab + pos * 32 + 4 * fq; const f32x4 cs = *(const LAS f32x4*)rp, sn = *(const LAS f32x4*)(rp + 16);
                            const f32x4 a = x[bj][0], b = x[bj][1];
                            x[bj][0] = a * cs - b * sn; x[bj][1] = b * cs + a * sn; }
                    }
                    bf16* o = isq ? (q + (size_t)row * 1024) : (kbuf + kvrow(row) * 1024);
                    o += colt + ((fq & 1) ? 12 + 4 * fq : 4 * fq); const float sc = isq ? C2 : 1.f;
#pragma unroll
                    for (int bj = 0; bj < 2; ++bj) { const f32x4 y0 = x[bj][0] * sc, y1 = x[bj][1] * sc; v4u w;
                        typedef unsigned u2_t __attribute__((ext_vector_type(2)));
                        const u2_t s0 = __builtin_amdgcn_permlane16_swap(pk2(y0[0], y0[1]), pk2(y1[0], y1[1]), false, false), s1 = __builtin_amdgcn_permlane16_swap(pk2(y0[2], y0[3]), pk2(y1[2], y1[3]), false, false);
                        w.x = s0[0]; w.y = s1[0]; w.z = s0[1]; w.w = s1[1];
                        *(v4u*)(o + 32 * bj) = w; }
                }
        } else {
            const bool isv = pn < 12; const int colt = (pn & 3) * 256, col0 = colt + wc * 32 + 8 * fq;
#pragma unroll
            for (int ai = 0; ai < 2; ++ai)
#pragma unroll
                for (int m = 0; m < 4; ++m) { const int row = row0 + ai * 128 + m * 16;
                    bf16* rowp = isv ? (vbuf + kvrow(row) * 1024 + col0) : (yab + (size_t)row * 2048 + 1024 + col0);
#pragma unroll
                    for (int bj = 0; bj < 2; ++bj) { f32x4 v0 = acc[ai][bj][m][0], v1 = acc[ai][bj][m][1];
                        if (isv && prompt) { float* o = nv + (size_t)row * 1024 + col0 + bj * 128; *(f32x4*)o = v0; *(f32x4*)(o + 4) = v1; }
                        if (!isv) { v0 = silu4(v0); v1 = silu4(v1); }
                        v4u w; w.x = pk2(v0[0], v0[1]); w.y = pk2(v0[2], v0[3]); w.z = pk2(v1[0], v1[1]); w.w = pk2(v1[2], v1[3]);
                        *(v4u*)(rowp + bj * 128) = w; } }
        }
    }
};

typedef _Float16 h2_t __attribute__((ext_vector_type(2)));
__device__ __forceinline__ unsigned ph2x(float a, float b) { h2_t h; h.x = (_Float16)a; h.y = (_Float16)b; return __builtin_bit_cast(unsigned, h); }
__device__ __forceinline__ float hlo(unsigned u) { return (float)__builtin_bit_cast(h2_t, u).x; }
__device__ __forceinline__ float hhi(unsigned u) { return (float)__builtin_bit_cast(h2_t, u).y; }
template <bool FIRST> struct EpiResT {
    static constexpr bool PERM = false, AFTER_DRAIN = false;
    const float *xp, *xs; float* out; bf16* xb; const float* ada;
    float* part; unsigned* cnt;
    template <int AI> __device__ __forceinline__ void store_half(const pg8::f32x4 (&acc)[2][2][4][2], const float* gate, const float* xin, int row0, int col0, int fq) const {
        typedef unsigned u2_t __attribute__((ext_vector_type(2)));
        f32x4 g[2][2];
#pragma unroll
        for (int bj = 0; bj < 2; ++bj)
#pragma unroll
            for (int n = 0; n < 2; ++n) g[bj][n] = *(const f32x4*)(gate + bj * 128 + n * 16);
        const int cb = col0 - 4 * fq + ((fq & 1) ? 12 + 4 * fq : 4 * fq);
#pragma unroll
        for (int m = 0; m < 4; ++m) { const size_t off = (size_t)(row0 + AI * 128 + m * 16) * 1024;
#pragma unroll
            for (int bj = 0; bj < 2; ++bj) {
                if (FIRST) {
                    const f32x4 y0 = *(const f32x4*)(xin + off + col0 + bj * 128) + g[bj][0] * acc[AI][bj][m][0], y1 = *(const f32x4*)(xin + off + col0 + bj * 128 + 16) + g[bj][1] * acc[AI][bj][m][1];
                    const u2_t s0 = __builtin_amdgcn_permlane16_swap(pk2(y0[0], y0[1]), pk2(y1[0], y1[1]), false, false), s1 = __builtin_amdgcn_permlane16_swap(pk2(y0[2], y0[3]), pk2(y1[2], y1[3]), false, false);
                    v4u w; w.x = s0[0]; w.y = s1[0]; w.z = s0[1]; w.w = s1[1];
                    *(v4u*)(xb + off + cb + bj * 128) = w;
                } else {
                    const v4u w = *(const v4u*)(xb + off + cb + bj * 128);
                    const u2_t s0 = __builtin_amdgcn_permlane16_swap(w.x, w.z, false, false), s1 = __builtin_amdgcn_permlane16_swap(w.y, w.w, false, false);
                    const f32x4 x0 = {bflo(s0[0]), bfhi(s0[0]), bflo(s1[0]), bfhi(s1[0])}, x1 = {bflo(s0[1]), bfhi(s0[1]), bflo(s1[1]), bfhi(s1[1])};
                    *(f32x4*)(out + off + col0 + bj * 128) = x0 + g[bj][0] * acc[AI][bj][m][0];
                    *(f32x4*)(out + off + col0 + bj * 128 + 16) = x1 + g[bj][1] * acc[AI][bj][m][1];
                } } }
    }
    template <int AI> __device__ __forceinline__ void finish_split(pg8::f32x4 (&acc)[2][2][4][2], const pg8::Unit& u, __amdgpu_buffer_rsrc_t rs, unsigned lo, int wcu, const float* gate, const float* xin, int row0, int col0, int fq) const {
        const int j = u.part;
#pragma unroll
        for (int jj = 1; jj < 4; ++jj) {
            const int js = (j + jj) & 3;
            const unsigned sb = (unsigned)((((u.tix * 4 + js) * 3 + (3 - jj)) * 4 + wcu) * 8) * 1024u;
            v4u t[8];
#pragma unroll
            for (int r = 0; r < 8; ++r) t[r] = __builtin_amdgcn_raw_buffer_load_b128(rs, lo, sb + (unsigned)(r * 1024), 0);
#pragma unroll
            for (int r = 0; r < 8; ++r) { f32x4 a0 = acc[AI][r >> 2][r & 3][0], a1 = acc[AI][r >> 2][r & 3][1];
                a0.x += hlo(t[r].x); a0.y += hhi(t[r].x); a0.z += hlo(t[r].y); a0.w += hhi(t[r].y); a1.x += hlo(t[r].z); a1.y += hhi(t[r].z); a1.z += hlo(t[r].w); a1.w += hhi(t[r].w);
                asm volatile("" : "+v"(a0), "+v"(a1) :: "memory");
                acc[AI][r >> 2][r & 3][0] = a0; acc[AI][r >> 2][r & 3][1] = a1; } }
        store_half<AI>(acc, gate, xin, row0, col0, fq);
    }
    __device__ __forceinline__ void operator()(pg8::f32x4 (&acc)[2][2][4][2], const pg8::Unit& u, int wr_, int wc_, int fr_, int fq_) const {
        int fr = fr_, fq = fq_, wr = wr_, wc = wc_; asm volatile("" : "+v"(fr), "+v"(fq), "+v"(wr), "+v"(wc));
        const int row0 = u.pm * 256 + wr * 64 + fr, col0 = u.pn * 256 + wc * 32 + 4 * fq;
        const int vec = (u.pm < 16) ? 0 : 1 + ((u.pm - 16) >> 4);
        const float* gate = ada + (size_t)vec * 3072 + 2048 + col0;
        const float* xin = (u.pm < 16) ? xp : xs;
        if (u.part >= 0) {
            const int j = u.part, lane = fq * 16 + fr, wru = __builtin_amdgcn_readfirstlane(wr), wcu = __builtin_amdgcn_readfirstlane(wc);
            const unsigned long long pa_ = (unsigned long long)part;
            float* part_u = (float*)(((unsigned long long)(unsigned)__builtin_amdgcn_readfirstlane((int)(pa_ >> 32)) << 32) | (unsigned)__builtin_amdgcn_readfirstlane((int)pa_));
            const __amdgpu_buffer_rsrc_t rs = __builtin_amdgcn_make_buffer_rsrc(part_u, 0, 24 << 20, 0x00020000); const unsigned lo = (unsigned)lane * 16u;
#pragma unroll
            for (int ai = 0; ai < 2; ++ai) { const int q = 2 * ai + wru;
                if (q != j) {
                    const unsigned base = (unsigned)((((u.tix * 4 + j) * 3 + ((q - j - 1) & 3)) * 4 + wcu) * 8) * 1024u;
#pragma unroll
                    for (int bj = 0; bj < 2; ++bj)
#pragma unroll
                        for (int m = 0; m < 4; ++m) { const f32x4 v0 = acc[ai][bj][m][0], v1 = acc[ai][bj][m][1]; v4u w; w.x = ph2x(v0.x, v0.y); w.y = ph2x(v0.z, v0.w); w.z = ph2x(v1.x, v1.y); w.w = ph2x(v1.z, v1.w);
                            __builtin_amdgcn_raw_buffer_store_b128(w, rs, lo, base + (unsigned)((bj * 4 + m) * 1024), 16  ); } } }
            asm volatile("s_waitcnt vmcnt(0)" ::: "memory");
            unsigned* c = cnt + u.tix * 32;
            if (lane == 0) (void)__hip_atomic_fetch_add(c, 1u, __ATOMIC_RELAXED, __HIP_MEMORY_SCOPE_AGENT);
            if (wru != (j & 1)) return;
            { unsigned sp = 0; while ((unsigned)__builtin_amdgcn_readfirstlane(__hip_atomic_load(c, __ATOMIC_RELAXED, __HIP_MEMORY_SCOPE_AGENT)) < 32u && ++sp < (1u << 22)) __builtin_amdgcn_s_sleep(1); }
            __builtin_amdgcn_fence(__ATOMIC_ACQUIRE, "agent");
            if ((j >> 1) == 0) finish_split<0>(acc, u, rs, lo, wcu, gate, xin, row0, col0, fq); else finish_split<1>(acc, u, rs, lo, wcu, gate, xin, row0, col0, fq);
            return;
        }
        store_half<0>(acc, gate, xin, row0, col0, fq); store_half<1>(acc, gate, xin, row0, col0, fq);
    }
};

struct EpiGate {
    static constexpr bool PERM = false, AFTER_DRAIN = false;
    bf16* pg;
    __device__ __forceinline__ void operator()(const pg8::f32x4 (&acc)[2][2][4][2], const pg8::Unit& u, int wr_, int wc_, int fr_, int fq_) const {
        int fr = fr_, fq = fq_, wr = wr_, wc = wc_; asm volatile("" : "+v"(fr), "+v"(fq), "+v"(wr), "+v"(wc));
        const int row0 = u.pm * 256 + wr * 64 + fr, ch0 = u.pn * 64 + 16 * wc + 4 * fq;
#pragma unroll
        for (int ai = 0; ai < 2; ++ai)
#pragma unroll
            for (int m = 0; m < 4; ++m) { bf16* rowp = pg + (size_t)(row0 + ai * 128 + m * 16) * 4096 + ch0;
                const f32x4 bg = acc[ai][0][m][0], cg = acc[ai][0][m][1], uu = acc[ai][1][m][0], z = acc[ai][1][m][1];
                const f32x4 pp = cg * uu, gt = bg * silu4(z);
                v2u w; w.x = pk2(pp[0], pp[1]); w.y = pk2(pp[2], pp[3]); *(v2u*)rowp = w;
                w.x = pk2(gt[0], gt[1]); w.y = pk2(gt[2], gt[3]); *(v2u*)(rowp + 2048) = w; }
    }
};

struct EpiGateConv {
    static constexpr bool PERM = false, AFTER_DRAIN = false;
    bf16* y2; float* sb; const float* cw; const float* cb; LAS float* xl;
    __device__ __forceinline__ void operator()(pg8::f32x4 (&acc)[2][2][4][2], const pg8::Unit& u, int wr_, int wc_, int fr_, int fq_) const {
        int fr = fr_, fq = fq_, wr = wr_, wc = wc_; asm volatile("" : "+v"(fr), "+v"(fq), "+v"(wr), "+v"(wc));
        const int row0 = u.pm * 256 + wr * 64 + fr, ch0 = u.pn * 64 + 16 * wc + 4 * fq, wid = wr * 4 + wc;
        const f32x4 w0 = *(const f32x4*)(cw + ch0), w1 = *(const f32x4*)(cw + 2048 + ch0), w2 = *(const f32x4*)(cw + 4096 + ch0), bb = *(const f32x4*)(cb + ch0);
#pragma unroll
        for (int ai = 0; ai < 2; ++ai) {
#pragma unroll
            for (int m = 0; m < 4; ++m) acc[ai][0][m][1] = acc[ai][0][m][1] * acc[ai][1][m][0];
            if (fr == 0)  *(LAS f32x4*)(xl + ((wid * 2 + ai) * 2 + 0) * 16 + 4 * fq) = acc[ai][0][0][1];
            if (fr == 15) *(LAS f32x4*)(xl + ((wid * 2 + ai) * 2 + 1) * 16 + 4 * fq) = acc[ai][0][3][1]; }
        asm volatile("s_waitcnt lgkmcnt(0)" ::: "memory"); __builtin_amdgcn_s_barrier();
        const int ow = wid ^ 4;
        const f32x4 z4 = {0.f, 0.f, 0.f, 0.f};
        f32x4 hp[2], hn[2];
        hp[0] = (wr == 0) ? z4 : *(const LAS f32x4*)(xl + ((ow * 2 + 0) * 2 + 1) * 16 + 4 * fq);
        hn[0] = (wr == 0) ? *(const LAS f32x4*)(xl + ((ow * 2 + 0) * 2 + 0) * 16 + 4 * fq) : *(const LAS f32x4*)(xl + ((ow * 2 + 1) * 2 + 0) * 16 + 4 * fq);
        hp[1] = (wr == 0) ? *(const LAS f32x4*)(xl + ((ow * 2 + 0) * 2 + 1) * 16 + 4 * fq) : *(const LAS f32x4*)(xl + ((ow * 2 + 1) * 2 + 1) * 16 + 4 * fq);
        hn[1] = (wr == 0) ? *(const LAS f32x4*)(xl + ((ow * 2 + 1) * 2 + 0) * 16 + 4 * fq) : z4;
        const bool f0 = (fr == 0), f15 = (fr == 15);
        v2u yw[4];
#pragma unroll
        for (int ai = 0; ai < 2; ++ai)
#pragma unroll
            for (int m = 0; m < 4; ++m) {
                const f32x4 c = acc[ai][0][m][1];
                f32x4 up, dn, pe, ne;
#pragma unroll
                for (int e = 0; e < 4; ++e) { up[e] = dppf<0x121>(c[e]); dn[e] = dppf<0x12F>(c[e]); }
                if (m > 0) {
#pragma unroll
                    for (int e = 0; e < 4; ++e) pe[e] = dppf<0x121>(acc[ai][0][m > 0 ? m - 1 : 0][1][e]); } else pe = hp[ai];
                if (m < 3) {
#pragma unroll
                    for (int e = 0; e < 4; ++e) ne[e] = dppf<0x12F>(acc[ai][0][m < 3 ? m + 1 : 3][1][e]); } else ne = hn[ai];
                const f32x4 pv = f0 ? pe : up, nx = f15 ? ne : dn;
                const f32x4 gt = acc[ai][0][m][0] * silu4(acc[ai][1][m][1]);
                const f32x4 y = gt * (w0 * pv + w1 * c + w2 * nx + bb);
                yw[m].x = pk2(y[0], y[1]); yw[m].y = pk2(y[2], y[3]);
                if (m & 1) {
                    typedef unsigned u2_t __attribute__((ext_vector_type(2)));
                    const u2_t s0 = __builtin_amdgcn_permlane16_swap(yw[m - (m & 1)].x, yw[m].x, false, false), s1 = __builtin_amdgcn_permlane16_swap(yw[m - (m & 1)].y, yw[m].y, false, false);
                    v4u w; w.x = s0[0]; w.y = s1[0]; w.z = s0[1]; w.w = s1[1];
                    *(v4u*)(y2 + (size_t)(row0 + ai * 128 + (m - 1 + (fq & 1)) * 16) * 2048 + ch0 - 4 * (fq & 1)) = w; }
                if (ai == 0 && m == 0) { if (wr == 0 && fr < 2) { float* d = sb + ((size_t)u.pm * 6 + fr) * 2048 + ch0; *(f32x4*)d = c; if (fr == 0) *(f32x4*)(d + 4 * 2048) = gt; } }
                if (ai == 1 && m == 3) { if (wr == 1 && fr >= 14) { float* d = sb + ((size_t)u.pm * 6 + 2 + (fr - 14)) * 2048 + ch0; *(f32x4*)d = c; if (fr == 15) *(f32x4*)(sb + ((size_t)u.pm * 6 + 5) * 2048 + ch0) = gt; } }
            }
    }
};
__device__ __forceinline__ void conv_fix_phase(const Params& p, int vcu, int G) {
    const float* sb = (const float*)(p.ws + WS_CSB); bf16* y2 = (bf16*)(p.ws + WS_YAB); const float* cw = p.in[I_CONVW]; const float* cb = p.in[I_CONVB];
    for (int it = vcu * NTHR + threadIdx.x; it < 60 * 2 * 512; it += G * NTHR) {
        const int c4 = (it & 511) * 4, side = (it >> 9) & 1, bd = it >> 10, seq = bd / 15, ta = 16 + seq * 16 + (bd % 15), tb = ta + 1;
        const float* A = sb + (size_t)ta * 6 * 2048 + c4; const float* B = sb + (size_t)tb * 6 * 2048 + c4;
        const f32x4 w0 = *(const f32x4*)(cw + c4), w1 = *(const f32x4*)(cw + 2048 + c4), w2 = *(const f32x4*)(cw + 4096 + c4), bb = *(const f32x4*)(cb + c4);
        f32x4 pv, c, nx, gt; int row;
        if (side == 0) { pv = *(const f32x4*)(A + 2 * 2048); c = *(const f32x4*)(A + 3 * 2048); nx = *(const f32x4*)(B); gt = *(const f32x4*)(A + 5 * 2048); row = ta * 256 + 255; }
        else           { pv = *(const f32x4*)(A + 3 * 2048); c = *(const f32x4*)(B); nx = *(const f32x4*)(B + 2048); gt = *(const f32x4*)(B + 4 * 2048); row = tb * 256; }
        const f32x4 y = gt * (w0 * pv + w1 * c + w2 * nx + bb);
        v2u w; w.x = pk2(y[0], y[1]); w.y = pk2(y[2], y[3]);
        *(v2u*)(y2 + (size_t)row * 2048 + c4) = w;
    }
}
constexpr int S3_LW = 16384, S3_LA = 24576;
constexpr int S3_XF = 0, S3_YF = 16384;
constexpr int S3_RAW = 34816;
constexpr int S3_LWD = 34816, S3_KK = 51200, S3_BB = 59392, S3_KD = 67584, S3_RR = 75776;
constexpr int S3_BKF = 83968, S3_VTF = 100352, S3_AKB = 108544, S3_TTF = 112640, S3_AOF = 116736, S3_ABB = 124928, S3_SF = 129024, S3_OBUF = 131072, S3_CST = 139264, S3_END = 141824;
constexpr int S3_CF = S3_END;
static_assert(S3_CF + 1280 <= LDS_MISC, "scan LDS map");
struct ScanPtrs { const bf16 *par, *pak, *pav, *pal; bf16 *ofp, *ofs, *ob; float* bn; const bf16* wupt; bf16* yab; float* smid; };
__device__ __forceinline__ unsigned pkh2(float lo, float hi) { typedef _Float16 h2_t __attribute__((ext_vector_type(2))); h2_t v = {(_Float16)lo, (_Float16)hi}; return __builtin_bit_cast(unsigned, v); }
__device__ __forceinline__ h8 cvt8(const f32x16& x, int o) { v4u w; w.x = pkh2(x[o], x[o + 1]); w.y = pkh2(x[o + 2], x[o + 3]); w.z = pkh2(x[o + 4], x[o + 5]); w.w = pkh2(x[o + 6], x[o + 7]); return __builtin_bit_cast(h8, w); }
#define SQ_HI(q) (((q) >> 2) & 1)
#define SQ_E(q) ((((q) >> 3) << 2) | ((q) & 3))

__device__ __forceinline__ void scan_chain(const Params& p, const ScanPtrs& sp, LAS unsigned char* lds, int chain, int half) {
    const int tid = threadIdx.x, lane = tid & 63; const int wid = __builtin_amdgcn_readfirstlane(tid >> 6);
    const bool smp = chain < 128; const int cc = smp ? chain : chain - 128;
    const int d = cc & 1, h = (cc >> 1) & 15, b = cc >> 5;
    const int T = smp ? TS : TP, tok0 = smp ? NTP + b * TS : b * TP;
    const int tb0 = (half == 1) ? 32 : 0, tb1 = (half == 0) ? 32 : T / 64, nseq = (half == 1) ? 4 : 2;
    __syncthreads();
    for (int i = tid; i < 640; i += NTHR) { const int a = i >> 6, j = i & 63, cj = h * 64 + j; float v;
        if (a == 0) v = p.in[I_MU][cj]; else if (a == 1) v = p.in[I_MU][1024 + cj]; else if (a == 2) v = p.in[I_MU][2048 + cj];
        else if (a == 3) v = p.in[I_MU][3072 + 64 * d + j]; else if (a == 4) v = p.in[I_MU][3200 + 64 * d + j];
        else if (a == 5) v = p.in[I_W0][d * 1024 + cj]; else if (a == 6) v = p.in[I_A0][d * 1024 + cj];
        else if (a == 7) v = p.in[I_KK][cj]; else if (a == 8) v = p.in[I_KA][cj]; else v = p.in[I_RK][cj];
        ((LAS float*)(lds + S3_CST))[i] = v; }
    const int r32o = lane & 31, hio = lane >> 5;
    f32x16 St[2];
    St[0] = (f32x16){}; St[1] = (f32x16){};
    if (wid < 2 && smp && half != 1) { const float* s0 = p.in[d ? I_SB : I_SF] + ((size_t)(b * 16 + h) * 64 + 32 * wid + r32o) * 64;
#pragma unroll
        for (int kt = 0; kt < 2; ++kt)
#pragma unroll
            for (int rg = 0; rg < 4; ++rg) { const f32x4 a = *(const f32x4*)(s0 + 32 * kt + 8 * rg + 4 * hio); St[kt][4 * rg] = a.x; St[kt][4 * rg + 1] = a.y; St[kt][4 * rg + 2] = a.z; St[kt][4 * rg + 3] = a.w; } }
    { const bool isv = (half == 1) && (wid >= 2);
      const float m0 = (isv && wid == 2) ? 1.f : 0.f, m1 = (isv && wid == 3) ? 1.f : 0.f;
      f32x16 e;
#pragma unroll
      for (int r = 0; r < 16; ++r) e[r] = (8 * (r >> 2) + 4 * hio + (r & 3) == r32o) ? 1.f : 0.f;
      St[0] = St[0] + e * m0; St[1] = St[1] + e * m1; }
    const unsigned lds0 = (unsigned)(uintptr_t)lds;
#define SC_DMA(tb_) do { const int tlo_ = d ? (T - 64 * ((tb_) + 1)) : (64 * (tb_)); int l_ = lane; asm volatile("" : "+v"(l_)); \
        for (int n_ = wid; n_ < 42; n_ += 8) { int sg_ = 8 * n_ + (l_ >> 3); sg_ = sg_ < 330 ? sg_ : 329; const int rho_ = sg_ / 5, arr_ = sg_ - 5 * rho_; \
            int t_ = tlo_ - 1 + rho_; t_ = t_ < 0 ? 0 : (t_ >= T ? T - 1 : t_); const size_t m_ = (size_t)(tok0 + t_); \
            const bf16* src_ = (arr_ == 0) ? sp.par + m_ * 1024 + h * 64 : (arr_ == 1) ? sp.pak + m_ * 1024 + h * 64 : (arr_ == 2) ? sp.pav + m_ * 1024 + h * 64 : (arr_ == 3) ? sp.pal + m_ * 256 + 64 * d : sp.pal + m_ * 256 + 128 + 64 * d; \
            glds16(src_ + (l_ & 7) * 8, (unsigned)__builtin_amdgcn_readfirstlane(lds0 + S3_RAW + n_ * 1024)); } } while (0)
#define SC_SIDE(tb_) do { int l_ = lane; asm volatile("" : "+v"(l_)); const int wq_ = wid - 4, pe_ = l_ >> 3, jg_ = l_ & 7; \
        const LAS float* cst_ = (const LAS float*)(lds + S3_CST) + 8 * jg_; const int tlo_ = d ? (T - 64 * ((tb_) + 1)) : (64 * (tb_)); \
        bf16x8 bf_[2][4][2];     \
        _Pragma("unroll") for (int mat_ = 0; mat_ < 2; ++mat_) { const bf16* wb_ = sp.wupt + ((size_t)(mat_ * 2 + d) * 1024 + h * 64) * 64 + (l_ & 15) * 64 + 8 * (l_ >> 4); \
            _Pragma("unroll") for (int nt_ = 0; nt_ < 4; ++nt_) { bf_[mat_][nt_][0] = *(const bf16x8*)(wb_ + 16 * nt_ * 64); bf_[mat_][nt_][1] = *(const bf16x8*)(wb_ + 16 * nt_ * 64 + 32); } } \
        _Pragma("unroll") for (int q_ = 0; q_ < 2; ++q_) { const int vw_ = 2 * wq_ + q_; \
            const int tmin_ = d ? (T - 1 - ((tb_) * 64 + 8 * vw_ + 7)) : ((tb_) * 64 + 8 * vw_); const int i_ = 8 * vw_ + (d ? (7 - pe_) : pe_), t_ = tmin_ + pe_; \
            const bool okp_ = t_ > 0, okn_ = t_ < T - 1; const LAS unsigned char* rw_ = lds + S3_RAW + (t_ - tlo_) * 640 + jg_ * 16; \
            _Pragma("unroll") for (int arr_ = 3; arr_ < 5; ++arr_) { v4u r0_ = *(const LAS v4u*)(rw_ + arr_ * 128), r1_ = *(const LAS v4u*)(rw_ + 640 + arr_ * 128), r2_ = *(const LAS v4u*)(rw_ + 1280 + arr_ * 128); \
                if (!okp_) r0_ = (v4u){0u, 0u, 0u, 0u}; if (!okn_) r2_ = (v4u){0u, 0u, 0u, 0u}; v4u o_; \
                _Pragma("unroll") for (int c2_ = 0; c2_ < 4; ++c2_) { \
                    const float xl_ = bflo(r1_[c2_]), xh_ = bfhi(r1_[c2_]); \
                    float yl_ = xl_ + cst_[64 * arr_ + 2 * c2_] * (0.5f * (bflo(r0_[c2_]) + bflo(r2_[c2_])) - xl_), yh_ = xh_ + cst_[64 * arr_ + 2 * c2_ + 1] * (0.5f * (bfhi(r0_[c2_]) + bfhi(r2_[c2_])) - xh_); \
                    if (arr_ == 3) { yl_ = 1.f - 2.f * frcp(1.f + __expf(2.f * yl_)); yh_ = 1.f - 2.f * frcp(1.f + __expf(2.f * yh_)); } \
                    o_[c2_] = pk2(yl_, yh_); } \
                *(LAS v4u*)(lds + (arr_ == 3 ? S3_LW : S3_LA) + (i_ * 64 + 8 * jg_) * 2) = o_; } } \
        asm volatile("s_waitcnt lgkmcnt(0)" ::: "memory"); \
        _Pragma("unroll") for (int mat_ = 0; mat_ < 2; ++mat_) { \
            const LAS unsigned char* ab_ = lds + (mat_ ? S3_LA : S3_LW) + ((16 * wq_ + (l_ & 15)) * 64 + 8 * (l_ >> 4)) * 2; \
            const bf16x8 a0_ = *(const LAS bf16x8*)ab_, a1_ = *(const LAS bf16x8*)(ab_ + 64); \
            f32x4 c_[4]; _Pragma("unroll") for (int nt_ = 0; nt_ < 4; ++nt_) { c_[nt_] = (f32x4){0.f, 0.f, 0.f, 0.f}; \
                c_[nt_] = __builtin_amdgcn_mfma_f32_16x16x32_bf16(a0_, bf_[mat_][nt_][0], c_[nt_], 0, 0, 0); c_[nt_] = __builtin_amdgcn_mfma_f32_16x16x32_bf16(a1_, bf_[mat_][nt_][1], c_[nt_], 0, 0, 0); } \
            asm volatile("s_waitcnt lgkmcnt(0)" ::: "memory");     \
            LAS unsigned short* out_ = (LAS unsigned short*)(lds + (mat_ ? S3_LA : S3_LW)) + (16 * wq_ + 4 * (l_ >> 4)) * 64 + (l_ & 15); \
              \
            _Pragma("unroll") for (int nt_ = 0; nt_ < 4; ++nt_) { const float bias_ = ((const LAS float*)(lds + S3_CST))[(mat_ ? 384 : 320) + 16 * nt_ + (l_ & 15)]; const float sc_ = mat_ ? 1.f : -0.6065306597126334f; \
                _Pragma("unroll") for (int r_ = 0; r_ < 4; ++r_) { const _Float16 hv_ = (_Float16)(sc_ * sigmf(bias_ + c_[nt_][r_])); out_[64 * r_ + 16 * nt_] = __builtin_bit_cast(unsigned short, hv_); } } } } while (0)
    SC_DMA(tb0);
    asm volatile("s_waitcnt vmcnt(0)" ::: "memory"); __syncthreads();
    if (wid >= 4) SC_SIDE(tb0);
    __syncthreads();
    for (int tb = tb0; tb < tb1; ++tb) {
        int ln = lane; asm volatile("" : "+v"(ln));
        const int r32 = ln & 31, hi = ln >> 5, pe = ln >> 3, jg = ln & 7;
        const int tmin = d ? (T - 1 - (tb * 64 + 8 * wid + 7)) : (tb * 64 + 8 * wid);
        const int i = 8 * wid + (d ? (7 - pe) : pe), t = tmin + pe;
        float rm[8], km[8], vm[8];
        { const LAS float* cst = (const LAS float*)(lds + S3_CST) + 8 * jg;
          const int tlo = d ? (T - 64 * (tb + 1)) : (64 * tb);
          const bool okp = t > 0, okn = t < T - 1;
          const LAS unsigned char* rw = lds + S3_RAW + (t - tlo) * 640 + jg * 16;
#pragma unroll
          for (int arr = 0; arr < 3; ++arr) { v4u r0 = *(const LAS v4u*)(rw + arr * 128), r1 = *(const LAS v4u*)(rw + 640 + arr * 128), r2 = *(const LAS v4u*)(rw + 1280 + arr * 128);
              if (!okp) r0 = (v4u){0u, 0u, 0u, 0u}; if (!okn) r2 = (v4u){0u, 0u, 0u, 0u};
#pragma unroll
              for (int c2 = 0; c2 < 4; ++c2) {
#pragma unroll
                  for (int hh = 0; hh < 2; ++hh) { const int jj = 2 * c2 + hh;
                      const float x = hh ? bfhi(r1[c2]) : bflo(r1[c2]), nb = hh ? (bfhi(r0[c2]) + bfhi(r2[c2])) : (bflo(r0[c2]) + bflo(r2[c2]));
                      const float y = x + cst[64 * arr + jj] * (0.5f * nb - x);
                      if (arr == 0) rm[jj] = y; else if (arr == 1) km[jj] = y; else vm[jj] = y; } } } }
        __syncthreads();
        { const LAS float* cst = (const LAS float*)(lds + S3_CST) + 8 * jg;
          const v4u lwv = *(const LAS v4u*)(lds + S3_LW + (i * 64 + 8 * jg) * 2), lav = *(const LAS v4u*)(lds + S3_LA + (i * 64 + 8 * jg) * 2);
          float lwd[8], av[8], kkr[8], kd[8]; float ssq = 0.f, bon = 0.f;
          const h8 lwh = __builtin_bit_cast(h8, lwv), lah = __builtin_bit_cast(h8, lav);
#pragma unroll
          for (int jj = 0; jj < 8; ++jj) {
              lwd[jj] = (float)lwh[jj];
              av[jj] = (float)lah[jj];
              kkr[jj] = km[jj] * cst[448 + jj]; ssq += kkr[jj] * kkr[jj];
              kd[jj] = km[jj] * (1.f + (av[jj] - 1.f) * cst[512 + jj]);
              bon += rm[jj] * kd[jj] * cst[576 + jj]; }
          ssq = sum8(ssq); bon = sum8(bon);
          const float rinv = frcp(fmaxf(__builtin_amdgcn_sqrtf(ssq), 1e-12f));
          if (jg == 0) sp.bn[(size_t)(tok0 + t) * 32 + h * 2 + d] = bon;
          *(LAS f32x4*)(lds + S3_LWD + (i * 64 + 8 * jg) * 4) = (f32x4){lwd[0], lwd[1], lwd[2], lwd[3]};
          *(LAS f32x4*)(lds + S3_LWD + (i * 64 + 8 * jg) * 4 + 16) = (f32x4){lwd[4], lwd[5], lwd[6], lwd[7]};
          v4u o;
#define SC_PACK(expr) do { _Pragma("unroll") for (int c2 = 0; c2 < 4; ++c2) { float x0, x1; { const int jj = 2 * c2; x0 = (expr); } { const int jj = 2 * c2 + 1; x1 = (expr); } o[c2] = pkh2(x0, x1); } } while (0)
          SC_PACK(kkr[jj] * rinv);                *(LAS v4u*)(lds + S3_KK + (i * 64 + 8 * jg) * 2) = o;
          SC_PACK(-(kkr[jj] * rinv) * av[jj]);    *(LAS v4u*)(lds + S3_BB + (i * 64 + 8 * jg) * 2) = o;
          SC_PACK(kd[jj]);                        *(LAS v4u*)(lds + S3_KD + (i * 64 + 8 * jg) * 2) = o;
          SC_PACK(rm[jj]);                        *(LAS v4u*)(lds + S3_RR + (i * 64 + 8 * jg) * 2) = o;
#undef SC_PACK
          { const int c = i >> 4, q = i & 15; LAS _Float16* vt = (LAS _Float16*)(lds + S3_VTF + c * 2048 + ((jg >> 2) * 32 + (jg & 3) * 8) * 32 + SQ_HI(q) * 16 + SQ_E(q) * 2);
#pragma unroll
            for (int jj = 0; jj < 8; ++jj) vt[jj * 16] = (_Float16)vm[jj]; }
        }
        __syncthreads();
        { const int c = wid >> 1, k = ln, ksx = k >> 4, q = k & 15, fo = SQ_HI(q) * 16 + SQ_E(q) * 2;
          float Lc[16];
          { float run = 0.f;
#pragma unroll
            for (int tau = 0; tau < 16; ++tau) { run += ((const LAS float*)(lds + S3_LWD))[(16 * c + tau) * 64 + k]; Lc[tau] = run; } }
          const float Lref = Lc[7];
          if ((wid & 1) == 0) {
              ((LAS float*)(lds + S3_SF))[(c * 2) * 64 + k] = __expf(Lref); ((LAS float*)(lds + S3_SF))[(c * 2 + 1) * 64 + k] = __expf(Lc[15] - Lref);
              LAS unsigned char* xf = lds + S3_XF + c * 4096 + ksx * 1024 + fo;
#pragma unroll
              for (int tau = 0; tau < 16; ++tau) { const float e1 = __expf((tau ? Lc[tau - 1] : 0.f) - Lref), e2 = __expf(Lc[tau] - Lref);
                  const float kkv = (float)((const LAS _Float16*)(lds + S3_KK))[(16 * c + tau) * 64 + k], rv = (float)((const LAS _Float16*)(lds + S3_RR))[(16 * c + tau) * 64 + k];
                  *(LAS _Float16*)(xf + ((tau + 2 * ksx) & 31) * 32) = (_Float16)(kkv * e1); *(LAS _Float16*)(xf + ((16 + tau + 2 * ksx) & 31) * 32) = (_Float16)(rv * e2); }
          } else {
              LAS unsigned char* yf = lds + S3_YF + c * 4096 + ksx * 1024 + fo;
              LAS unsigned char* bk = lds + S3_BKF + c * 4096 + (k >> 5) * 2048 + (k & 31) * 32;
              float bt[16], kt2[16];
#pragma unroll
              for (int tau = 0; tau < 16; ++tau) { const float e3 = __expf(Lref - Lc[tau]);
                  bt[tau] = (float)((const LAS _Float16*)(lds + S3_BB))[(16 * c + tau) * 64 + k] * e3; kt2[tau] = (float)((const LAS _Float16*)(lds + S3_KD))[(16 * c + tau) * 64 + k] * e3;
                  *(LAS _Float16*)(yf + ((tau + 2 * ksx) & 31) * 32) = (_Float16)bt[tau]; *(LAS _Float16*)(yf + ((16 + tau + 2 * ksx) & 31) * 32) = (_Float16)kt2[tau]; }
              *(LAS v4u*)(bk)             = (v4u){pkh2(bt[0], bt[1]), pkh2(bt[2], bt[3]), pkh2(bt[8], bt[9]), pkh2(bt[10], bt[11])};
              *(LAS v4u*)(bk + 16)        = (v4u){pkh2(bt[4], bt[5]), pkh2(bt[6], bt[7]), pkh2(bt[12], bt[13]), pkh2(bt[14], bt[15])};
              *(LAS v4u*)(bk + 1024)      = (v4u){pkh2(kt2[0], kt2[1]), pkh2(kt2[2], kt2[3]), pkh2(kt2[8], kt2[9]), pkh2(kt2[10], kt2[11])};
              *(LAS v4u*)(bk + 1024 + 16) = (v4u){pkh2(kt2[4], kt2[5]), pkh2(kt2[6], kt2[7]), pkh2(kt2[12], kt2[13]), pkh2(kt2[14], kt2[15])};
          } }
        __syncthreads();
        if (tb + 1 < tb1) SC_DMA(tb + 1);
        if (wid >= 4) { const int ci = tid - 256;
            for (int e = ci; e < 320; e += 256) { const int c = e >> 6, k = e & 63; const LAS float* sf = (const LAS float*)(lds + S3_SF);
                ((LAS float*)(lds + S3_CF))[e] = (c == 0) ? sf[k] : (c == 4) ? sf[7 * 64 + k] : sf[(2 * c) * 64 + k] * sf[(2 * c - 1) * 64 + k]; } }
        if (wid < 4) { const int c = wid, fl = r32 * 32 + hi * 16;
            f32x16 G = (f32x16){};
#pragma unroll
            for (int ks = 0; ks < 4; ++ks) { const int flr = ((r32 + 2 * ks) & 31) * 32 + hi * 16;
                G = __builtin_amdgcn_mfma_f32_32x32x16_f16(*(const LAS h8*)(lds + S3_YF + c * 4096 + ks * 1024 + flr), *(const LAS h8*)(lds + S3_XF + c * 4096 + ks * 1024 + flr), G, 0, 0, 0); }
            const int n = r32, tau = n & 15; const bool isr = n >= 16;
#pragma unroll
            for (int r = 0; r < 16; ++r) { const int j = (r & 3) + 8 * ((r >> 2) & 1) + 4 * hi; const bool keep = isr ? (j <= tau) : (j < tau); G[r] = keep ? G[r] : 0.f; }
            const h8 z8 = (h8){};
            if (!isr) {
#pragma unroll
                for (int r = 0; r < 8; ++r) { const int j = (r & 3) + 8 * (r >> 2) + 4 * hi; ((LAS float*)(lds + S3_ABB))[c * 256 + j * 16 + tau] = G[r]; }
                *(LAS h8*)(lds + S3_AKB + c * 1024 + fl) = cvt8(G, 8);
                *(LAS h8*)(lds + S3_AOF + c * 2048 + fl) = z8; *(LAS h8*)(lds + S3_AOF + c * 2048 + 1024 + fl) = z8;
            } else {
                *(LAS h8*)(lds + S3_AKB + c * 1024 + fl) = z8;
                *(LAS h8*)(lds + S3_AOF + c * 2048 + fl) = cvt8(G, 0); *(LAS h8*)(lds + S3_AOF + c * 2048 + 1024 + fl) = cvt8(G, 8);
            }
            asm volatile("s_waitcnt lgkmcnt(0)" ::: "memory");
            { const int ii = ln & 15; float Tc[16]; const LAS float* ab = (const LAS float*)(lds + S3_ABB) + c * 256;
#pragma unroll
              for (int ta = 15; ta >= 0; --ta) { float acc0 = (ta == ii) ? 1.f : 0.f, acc1 = 0.f, acc2 = 0.f, acc3 = 0.f;
                  if ((ta & 3) == 3) asm volatile("" ::: "memory");
#pragma unroll
                  for (int m = ta + 1; m < 16; ++m) { const float pr = ab[ta * 16 + m] * Tc[m]; if ((m & 3) == 0) acc0 += pr; else if ((m & 3) == 1) acc1 += pr; else if ((m & 3) == 2) acc2 += pr; else acc3 += pr; }
                  Tc[ta] = (acc0 + acc1) + (acc2 + acc3); }
              v4u w0, w1;
              w0.x = pkh2(Tc[0], Tc[1]); w0.y = pkh2(Tc[2], Tc[3]); w0.z = pkh2(Tc[8], Tc[9]); w0.w = pkh2(Tc[10], Tc[11]);
              w1.x = pkh2(Tc[4], Tc[5]); w1.y = pkh2(Tc[6], Tc[7]); w1.z = pkh2(Tc[12], Tc[13]); w1.w = pkh2(Tc[14], Tc[15]);
              if (ln < 16) { *(LAS v4u*)(lds + S3_TTF + c * 1024 + ln * 32) = w0; *(LAS v4u*)(lds + S3_TTF + c * 1024 + ln * 32 + 16) = w1; }
              else if (ln < 32) { *(LAS v4u*)(lds + S3_TTF + c * 1024 + ln * 32) = (v4u){0u, 0u, 0u, 0u}; *(LAS v4u*)(lds + S3_TTF + c * 1024 + ln * 32 + 16) = (v4u){0u, 0u, 0u, 0u}; } }
        }
        asm volatile("s_waitcnt vmcnt(0)" ::: "memory");
        __syncthreads();
        if (wid >= 4 && tb + 1 < tb1) SC_SIDE(tb + 1);
        if (wid < nseq) { const int fl = r32 * 32 + hi * 16; const bool virt = wid >= 2; const int vtile = wid & 1;
#pragma unroll 1
            for (int c = 0; c < 4; ++c) {
                f32x4 cf[8];
#pragma unroll
                for (int kt = 0; kt < 2; ++kt)
#pragma unroll
                    for (int rg = 0; rg < 4; ++rg) cf[kt * 4 + rg] = *(const LAS f32x4*)(lds + S3_CF + c * 256 + (32 * kt + 8 * rg + 4 * hi) * 4);
                const LAS unsigned char* xf = lds + S3_XF + c * 4096 + hi * 16;
                const h8 x0 = *(const LAS h8*)(xf + r32 * 32), x1 = *(const LAS h8*)(xf + 1024 + ((r32 + 2) & 31) * 32), x2 = *(const LAS h8*)(xf + 2048 + ((r32 + 4) & 31) * 32), x3 = *(const LAS h8*)(xf + 3072 + ((r32 + 6) & 31) * 32);
                h8 vfr = *(const LAS h8*)(lds + S3_VTF + c * 2048 + vtile * 1024 + fl); if (virt) vfr = (h8){};
                const h8 akb = *(const LAS h8*)(lds + S3_AKB + c * 1024 + fl), ttf = *(const LAS h8*)(lds + S3_TTF + c * 1024 + fl);
                const h8 ao0 = *(const LAS h8*)(lds + S3_AOF + c * 2048 + fl), ao1 = *(const LAS h8*)(lds + S3_AOF + c * 2048 + 1024 + fl);
                const h8 bk00 = *(const LAS h8*)(lds + S3_BKF + c * 4096 + fl), bk01 = *(const LAS h8*)(lds + S3_BKF + c * 4096 + 1024 + fl),
                         bk10 = *(const LAS h8*)(lds + S3_BKF + c * 4096 + 2048 + fl), bk11 = *(const LAS h8*)(lds + S3_BKF + c * 4096 + 3072 + fl);
#pragma unroll
                for (int kt = 0; kt < 2; ++kt)
#pragma unroll
                    for (int rg = 0; rg < 4; ++rg) { const f32x4 f = cf[kt * 4 + rg]; St[kt][4 * rg] *= f.x; St[kt][4 * rg + 1] *= f.y; St[kt][4 * rg + 2] *= f.z; St[kt][4 * rg + 3] *= f.w; }
                const h8 s0 = cvt8(St[0], 0), s1 = cvt8(St[0], 8), s2 = cvt8(St[1], 0), s3 = cvt8(St[1], 8);
                f32x16 P = __builtin_amdgcn_mfma_f32_32x32x16_f16(akb, vfr, (f32x16){}, 0, 0, 0);
                P = __builtin_amdgcn_mfma_f32_32x32x16_f16(x0, s0, P, 0, 0, 0);
                P = __builtin_amdgcn_mfma_f32_32x32x16_f16(x1, s1, P, 0, 0, 0);
                P = __builtin_amdgcn_mfma_f32_32x32x16_f16(x2, s2, P, 0, 0, 0);
                P = __builtin_amdgcn_mfma_f32_32x32x16_f16(x3, s3, P, 0, 0, 0);
                const h8 zf = cvt8(P, 0);
                f32x16 Ut = __builtin_amdgcn_mfma_f32_32x32x16_f16(ttf, zf, (f32x16){}, 0, 0, 0);
                const h8 uf = cvt8(Ut, 0);
                St[0] = __builtin_amdgcn_mfma_f32_32x32x16_f16(bk00, uf, St[0], 0, 0, 0);
                St[1] = __builtin_amdgcn_mfma_f32_32x32x16_f16(bk10, uf, St[1], 0, 0, 0);
                St[0] = __builtin_amdgcn_mfma_f32_32x32x16_f16(bk01, vfr, St[0], 0, 0, 0);
                St[1] = __builtin_amdgcn_mfma_f32_32x32x16_f16(bk11, vfr, St[1], 0, 0, 0);
                P = __builtin_amdgcn_mfma_f32_32x32x16_f16(ao0, uf, P, 0, 0, 0);
                P = __builtin_amdgcn_mfma_f32_32x32x16_f16(ao1, vfr, P, 0, 0, 0);
                if (!virt) {
#pragma unroll
                    for (int r = 8; r < 16; ++r) { const int tau = (r & 3) + 8 * ((r >> 2) & 1) + 4 * hi;
                        *(LAS unsigned short*)(lds + S3_OBUF + ((16 * c + tau) * 64 + 32 * vtile + r32) * 2) = (unsigned short)f2bf(P[r]); }
                } else {
                    _Float16* mt = (_Float16*)(sp.yab + ((size_t)(NTP + b * TS + (tb * 64 + 16 * c - 2048) + 2048 * d) * 2048 + 1024)) + h * 64 + 32 * vtile + r32;
#pragma unroll
                    for (int r = 8; r < 16; ++r) { const int tau = (r & 3) + 8 * ((r >> 2) & 1) + 4 * hi; mt[(size_t)tau * 2048] = (_Float16)P[r]; }
                }
            }
#pragma unroll
            for (int kt = 0; kt < 2; ++kt)
#pragma unroll
                for (int rg = 0; rg < 4; ++rg) { const f32x4 f = *(const LAS f32x4*)(lds + S3_CF + 4 * 256 + (32 * kt + 8 * rg + 4 * hi) * 4);
                    St[kt][4 * rg] *= f.x; St[kt][4 * rg + 1] *= f.y; St[kt][4 * rg + 2] *= f.z; St[kt][4 * rg + 3] *= f.w; }
        }
        __syncthreads();
        { const int fi = tid >> 3, ch = tid & 7; const int ft = d ? (T - 1 - (tb * 64 + fi)) : (tb * 64 + fi);
          const v4u v = *(const LAS v4u*)(lds + S3_OBUF + (fi * 64 + ch * 8) * 2);
          bf16* dst = d ? (sp.ob + (size_t)(tok0 + ft) * 1024) : (smp ? sp.ofs + (size_t)(b * TS + ft) * 1024 : sp.ofp + (size_t)(tok0 + ft) * 1024);
          *(v4u*)(dst + h * 64 + ch * 8) = v; }
    }
#undef SC_DMA
#undef SC_SIDE
    if (wid < 2 && half != 1) { float* o = smp ? sp.smid + ((size_t)chain * 64 + 32 * wid + r32o) * 64 : (float*)((unsigned char*)p.out + (d ? O_SB : O_SF)) + ((size_t)(b * 16 + h) * 64 + 32 * wid + r32o) * 64;
#pragma unroll
        for (int kt = 0; kt < 2; ++kt)
#pragma unroll
            for (int rg = 0; rg < 4; ++rg) *(f32x4*)(o + 32 * kt + 8 * rg + 4 * hio) = (f32x4){St[kt][4 * rg], St[kt][4 * rg + 1], St[kt][4 * rg + 2], St[kt][4 * rg + 3]}; }
}
__device__ __forceinline__ void scan_phase(const Params& p, LAS unsigned char* lds, int vcu, int G) {
    ScanPtrs sp; sp.par = (const bf16*)(p.ws + X_PAR); sp.pak = (const bf16*)(p.ws + X_PAK); sp.pav = (const bf16*)((unsigned char*)p.out + O_PAV); sp.pal = (const bf16*)(p.ws + X_PAL);
    sp.ofp = (bf16*)(p.ws + X_OFP); sp.ofs = (bf16*)((unsigned char*)p.out + O_OFS); sp.ob = (bf16*)((unsigned char*)p.out + O_OB); sp.bn = (float*)(p.ws + WS_BN); sp.wupt = (const bf16*)(p.ws + WS_WUPT);
    sp.yab = (bf16*)(p.ws + WS_YAB); sp.smid = (float*)(p.ws + X_SMID);
    for (int j = vcu; j < 768; j += G) { const int chain = (j < 256) ? (j >> 1) : 128 + (j - 256), half = (j < 256) ? (j & 1) : -1; scan_chain(p, sp, lds, chain, half); }
}
__device__ __forceinline__ void scan_fixup_phase(const Params& p, int vcu, int G) {
    const int lane = threadIdx.x & 63, r32 = lane & 31, hi = lane >> 5; const int wid = __builtin_amdgcn_readfirstlane(threadIdx.x >> 6);
    const bf16* yab = (const bf16*)(p.ws + WS_YAB); const float* smid = (const float*)(p.ws + X_SMID);
    bf16* ofs = (bf16*)((unsigned char*)p.out + O_OFS); bf16* ob = (bf16*)((unsigned char*)p.out + O_OB);
    for (int it = vcu; it < 1024; it += G) { const int chain = it >> 3, slab = it & 7, d = chain & 1, h = (chain >> 1) & 15, b = chain >> 5;
        const int pp = slab * 256 + wid * 32 + r32;
        const _Float16* mrow = (const _Float16*)(yab + ((size_t)(NTP + b * TS + pp + 2048 * d) * 2048 + 1024)) + h * 64 + 8 * hi;
        h8 mf[4];
#pragma unroll
        for (int ks = 0; ks < 4; ++ks) mf[ks] = *(const h8*)(mrow + 16 * ks);
        const int t = d ? (2047 - pp) : (2048 + pp);
        bf16* orow = (d ? ob + (size_t)(NTP + b * TS + t) * 1024 : ofs + (size_t)(b * TS + t) * 1024) + h * 64 + 4 * hi;
#pragma unroll
        for (int vt = 0; vt < 2; ++vt) { const float* srow = smid + ((size_t)chain * 64 + 32 * vt + r32) * 64 + 8 * hi;
            f32x16 D = (f32x16){};
#pragma unroll
            for (int ks = 0; ks < 4; ++ks) { const f32x4 a = *(const f32x4*)(srow + 16 * ks), c = *(const f32x4*)(srow + 16 * ks + 4);
                v4u w; w.x = pkh2(a.x, a.y); w.y = pkh2(a.z, a.w); w.z = pkh2(c.x, c.y); w.w = pkh2(c.z, c.w);
                D = __builtin_amdgcn_mfma_f32_32x32x16_f16(__builtin_bit_cast(h8, w), mf[ks], D, 0, 0, 0); }
#pragma unroll
            for (int g4 = 0; g4 < 4; ++g4) { bf16* o = orow + 32 * vt + 8 * g4; const v2u cur = *(const v2u*)o;
                v2u w; w.x = pk2(bflo(cur.x) + D[4 * g4], bfhi(cur.x) + D[4 * g4 + 1]); w.y = pk2(bflo(cur.y) + D[4 * g4 + 2], bfhi(cur.y) + D[4 * g4 + 3]); *(v2u*)o = w; } }
    }
}
__device__ __forceinline__ void post_scan_phase(const Params& p, int vcu, int G) {
    const int lane = threadIdx.x & 63, wid = threadIdx.x >> 6, gw = vcu * NWAVES + wid, NGW = G * NWAVES;
    const bf16* pav = (const bf16*)((unsigned char*)p.out + O_PAV); const bf16* ofp = (const bf16*)(p.ws + X_OFP); const bf16* ofs = (const bf16*)((unsigned char*)p.out + O_OFS);
    const bf16* ob = (const bf16*)((unsigned char*)p.out + O_OB); const float* bn = (const float*)(p.ws + WS_BN); bf16* yab = (bf16*)(p.ws + WS_YAB);
    for (int it = gw; it < NT * 4; it += NGW) {
        const int m = it >> 2, c0 = (it & 3) * 256 + 4 * lane, head = c0 >> 6;
        const int T = (m < NTP) ? TP : TS, t = (m < NTP) ? (m & 255) : ((m - NTP) & 4095);
        const v2u of = (m < NTP) ? *(const v2u*)(ofp + (size_t)m * 1024 + c0) : *(const v2u*)(ofs + (size_t)(m - NTP) * 1024 + c0);
        const v2u obv = *(const v2u*)(ob + (size_t)m * 1024 + c0);
        float o[4] = {bflo(of.x) + bflo(obv.x), bfhi(of.x) + bfhi(obv.x), bflo(of.y) + bflo(obv.y), bfhi(of.y) + bfhi(obv.y)};
        const float mean = sum16((o[0] + o[1]) + (o[2] + o[3])) * (1.f / 64.f);
        float dv[4], q = 0.f;
#pragma unroll
        for (int e = 0; e < 4; ++e) { dv[e] = o[e] - mean; q += dv[e] * dv[e]; }
        const float rs = rsqrtf(sum16(q) * (1.f / 64.f) + 64e-5f);
        const v2u vc = *(const v2u*)(pav + (size_t)m * 1024 + c0);
        v2u vp = {0u, 0u}, vn = {0u, 0u};
        if (t > 0) vp = *(const v2u*)(pav + (size_t)(m - 1) * 1024 + c0);
        if (t < T - 1) vn = *(const v2u*)(pav + (size_t)(m + 1) * 1024 + c0);
        const f32x4 muv = *(const f32x4*)(p.in[I_MU] + 2048 + c0), lw = *(const f32x4*)(p.in[I_LNW] + c0), lb = *(const f32x4*)(p.in[I_LNB] + c0);
        const float vcf[4] = {bflo(vc.x), bfhi(vc.x), bflo(vc.y), bfhi(vc.y)}, vpf[4] = {bflo(vp.x), bfhi(vp.x), bflo(vp.y), bfhi(vp.y)}, vnf[4] = {bflo(vn.x), bfhi(vn.x), bflo(vn.y), bfhi(vn.y)};
        const float bsum = bn[(size_t)m * 32 + head * 2] + bn[(size_t)m * 32 + head * 2 + 1];
        const v2u gav = *(const v2u*)(yab + (size_t)m * 2048 + c0);
        const float ga[4] = {bflo(gav.x), bfhi(gav.x), bflo(gav.y), bfhi(gav.y)};
        float y[4];
#pragma unroll
        for (int e = 0; e < 4; ++e) { const float vmix = vcf[e] + muv[e] * (0.5f * (vpf[e] + vnf[e]) - vcf[e]); y[e] = (dv[e] * rs * lw[e] + lb[e] + bsum * vmix) * ga[e]; }
        v2u w; w.x = pk2(y[0], y[1]); w.y = pk2(y[2], y[3]);
        *(v2u*)(yab + (size_t)m * 2048 + c0) = w;
    }
}
constexpr int AT_K = 0, AT_V = 49152, AT_SLOT = 16384, AT_X = 0;
#define AT_WAIT_BAR(N) asm volatile("s_waitcnt vmcnt(" #N ") lgkmcnt(0)\n\ts_barrier" ::: "memory")
__device__ __forceinline__ unsigned cvtpk(float lo, float hi) { typedef float f2_t __attribute__((ext_vector_type(2))); typedef __bf16 b2_t __attribute__((ext_vector_type(2))); f2_t v = {lo, hi}; b2_t b = __builtin_convertvector(v, b2_t); return __builtin_bit_cast(unsigned, b); }
__device__ __forceinline__ s16x4 vtr(const LAS unsigned char* p) { typedef short v4i16_t __attribute__((ext_vector_type(4))); return __builtin_bit_cast(s16x4, __builtin_amdgcn_ds_read_tr16_b64_v4i16((LAS v4i16_t*)p)); }
struct AttnCtx { const bf16 *q, *kp, *ks, *vp, *vs; bf16* yab; const float *kmax, *subln; float lam, kbase; };

__device__ __forceinline__ void attn_unit(const AttnCtx& A, LAS unsigned char* lds, int u) {
    const int tid = threadIdx.x, lane = tid & 63, r32 = lane & 31, hi = lane >> 5; const int wid = __builtin_amdgcn_readfirstlane(tid >> 6);
    const int qg = wid >> 1, comp = wid & 1;
    const bool smp = u < 1024; int b, h, qb;
    if (smp) { const int combo = u >> 5; b = combo >> 3; h = combo & 7; qb = u & 31; } else { const int pu = u - 1024; b = pu >> 4; h = (pu >> 1) & 7; qb = pu & 1; }
    const int tokq0 = (smp ? NTP + b * TS : b * TP) + qb * 128;
    const bf16* Km = smp ? A.ks + (size_t)b * TKS * 1024 : A.kp + (size_t)b * TP * 1024;
    const bf16* Vm = smp ? A.vs + (size_t)b * TKS * 1024 : A.vp + (size_t)b * TP * 1024;
    const int nkt = smp ? (TKS / 64) : (TP / 64);
    const bf16* ksrc0 = Km + (size_t)lane * 1024 + h * 128 + wid * 8;
    const bf16* vsrc0 = Vm + (size_t)(16 * (wid & 3) + (lane >> 2)) * 1024 + h * 128 + (wid >> 2) * 32 + (lane & 3) * 8;
    const unsigned lds0 = (unsigned)(uintptr_t)lds;
#define AT_DMA(t, slot) do { const size_t go_ = (size_t)(t) * 64 * 1024; \
        glds16(ksrc0 + go_,      (unsigned)__builtin_amdgcn_readfirstlane(lds0 + AT_K + (slot) * AT_SLOT + wid * 1024)); \
        glds16(ksrc0 + go_ + 64, (unsigned)__builtin_amdgcn_readfirstlane(lds0 + AT_K + (slot) * AT_SLOT + (wid + 8) * 1024)); \
        glds16(vsrc0 + go_,      (unsigned)__builtin_amdgcn_readfirstlane(lds0 + AT_V + (slot) * AT_SLOT + wid * 1024)); \
        glds16(vsrc0 + go_ + 64, (unsigned)__builtin_amdgcn_readfirstlane(lds0 + AT_V + (slot) * AT_SLOT + (wid + 8) * 1024)); } while (0)
    AT_DMA(0, 0);
    bf16x8 qf[4];
    const bf16* qrow = A.q + (size_t)(tokq0 + qg * 32 + r32) * 1024 + h * 128 + comp * 64 + hi * 8;
#pragma unroll
    for (int d0 = 0; d0 < 4; ++d0) qf[d0] = *(const bf16x8*)(qrow + d0 * 16);
    float mq;
    { float ss0 = 0.f;
#pragma unroll
      for (int d0 = 0; d0 < 4; ++d0)
#pragma unroll
          for (int e = 0; e < 8; ++e) { const float x0 = bf2f((unsigned short)qf[d0][e]); ss0 += x0 * x0; }
      ss0 += __shfl_xor(ss0, 32);
      float kb0 = A.kbase;
      if (smp) kb0 = fmaxf(kb0, sqrtf(A.kmax[(b * 8 + h) * 2 + comp]) * 1.01f);
      mq = sqrtf(ss0) * kb0; }
    f32x16 negm;
#pragma unroll
    for (int r = 0; r < 16; ++r) negm[r] = -mq;
    f32x16 O[4];
#pragma unroll
    for (int i = 0; i < 4; ++i) O[i] = (f32x16){};
    float l = 0.f;
    const int vbase = ((lane >> 4) & 1) * 32 + (lane & 3) * 8 + (4 * hi + ((lane & 15) >> 2)) * 64;
    int slot = 0;
    for (int t = 0; t < nkt; ++t) {
        const int nslot = (slot == 2) ? 0 : slot + 1;
        if (t + 1 < nkt) { AT_DMA(t + 1, nslot); AT_WAIT_BAR(4); } else { AT_WAIT_BAR(0); }
        const LAS unsigned char* Ks = lds + AT_K + slot * AT_SLOT + (comp * 8 + hi) * 1024 + r32 * 16;
        const LAS unsigned char* Vs = lds + AT_V + slot * AT_SLOT + vbase;
        bf16x8 pw[4];
#pragma unroll
        for (int kh = 0; kh < 2; ++kh) {
            f32x16 s; bf16x8 kf[4];
#pragma unroll
            for (int d0 = 0; d0 < 4; ++d0) kf[d0] = *(const LAS bf16x8*)(Ks + d0 * 2048 + kh * 512);
            s = __builtin_amdgcn_mfma_f32_32x32x16_bf16(kf[0], qf[0], negm, 0, 0, 0);
#pragma unroll
            for (int d0 = 1; d0 < 4; ++d0) s = __builtin_amdgcn_mfma_f32_32x32x16_bf16(kf[d0], qf[d0], s, 0, 0, 0);
            float ls = 0.f;
#pragma unroll
            for (int r = 0; r < 16; ++r) { s[r] = __builtin_amdgcn_exp2f(s[r]); ls += s[r]; }
            l += ls;
#pragma unroll
            for (int sx = 0; sx < 2; ++sx) { v4u w; w.x = cvtpk(s[8 * sx + 0], s[8 * sx + 1]); w.y = cvtpk(s[8 * sx + 2], s[8 * sx + 3]); w.z = cvtpk(s[8 * sx + 4], s[8 * sx + 5]); w.w = cvtpk(s[8 * sx + 6], s[8 * sx + 7]);
                pw[2 * kh + sx] = __builtin_bit_cast(bf16x8, w); }
        }
#pragma unroll
        for (int dvb = 0; dvb < 4; ++dvb) { bf16x8 vf[4];
#pragma unroll
            for (int ks = 0; ks < 4; ++ks) { const s16x4 lo = vtr(Vs + dvb * 4096 + ks * 1024), hh = vtr(Vs + dvb * 4096 + ks * 1024 + 512);
                vf[ks] = (bf16x8){lo[0], lo[1], lo[2], lo[3], hh[0], hh[1], hh[2], hh[3]}; }
#pragma unroll
            for (int ks = 0; ks < 4; ++ks) O[dvb] = __builtin_amdgcn_mfma_f32_32x32x16_bf16(vf[ks], pw[ks], O[dvb], 0, 0, 0);
        }
        slot = nslot;
    }
    l += __shfl_xor(l, 32);
    const float il = (comp ? A.lam : 1.f) / l;
    AT_WAIT_BAR(0);
    LAS float* xb = (LAS float*)(lds + AT_X + qg * 16384) + lane;
    if (comp == 1) {
#pragma unroll
        for (int dvb = 0; dvb < 4; ++dvb)
#pragma unroll
            for (int r = 0; r < 16; ++r) xb[(dvb * 16 + r) * 64] = O[dvb][r] * il;
    }
    AT_WAIT_BAR(0);
    if (comp == 0) {
        float ss = 0.f;
#pragma unroll
        for (int dvb = 0; dvb < 4; ++dvb)
#pragma unroll
            for (int r = 0; r < 16; ++r) { const float o = O[dvb][r] * il - xb[(dvb * 16 + r) * 64]; O[dvb][r] = o; ss += o * o; }
        ss += __shfl_xor(ss, 32);
        const float rinv = rsqrtf(ss * (1.f / 128.f) + 1e-6f) * 0.8f;
        bf16* yrow = A.yab + (size_t)(tokq0 + qg * 32 + r32) * 2048 + 1024 + h * 128 + 4 * hi;
#pragma unroll
        for (int dvb = 0; dvb < 4; ++dvb)
#pragma unroll
            for (int gq = 0; gq < 4; ++gq) { const int dv0 = 32 * dvb + 8 * gq;
                const v2u gb = *(const v2u*)(yrow + dv0); const f32x4 sw = *(const f32x4*)(A.subln + dv0 + 4 * hi);
                const float y0 = O[dvb][4 * gq + 0] * rinv * sw[0] * bflo(gb.x), y1 = O[dvb][4 * gq + 1] * rinv * sw[1] * bfhi(gb.x),
                            y2 = O[dvb][4 * gq + 2] * rinv * sw[2] * bflo(gb.y), y3 = O[dvb][4 * gq + 3] * rinv * sw[3] * bfhi(gb.y);
                v2u w; w.x = pk2(y0, y1); w.y = pk2(y2, y3); *(v2u*)(yrow + dv0) = w; }
    }
    AT_WAIT_BAR(0);
#undef AT_DMA
}
__device__ __forceinline__ void attn_phase(const Params& p, LAS unsigned char* lds, int vcu, int G) {
    AttnCtx A; A.q = (const bf16*)(p.ws + X_Q); A.kp = (const bf16*)(p.ws + X_KP); A.ks = (const bf16*)(p.ws + X_KS);
    A.vp = (const bf16*)((unsigned char*)p.out + O_VP); A.vs = (const bf16*)((unsigned char*)p.out + O_VS); A.yab = (bf16*)(p.ws + WS_YAB);
    A.kmax = (const float*)(p.ws + WS_KMAX); A.subln = p.in[I_SUBLN];
    const int lane = threadIdx.x & 63;
    { const float* lv = p.in[I_LAM]; const float s01 = wave_sum(lv[lane] * lv[64 + lane]), s23 = wave_sum(lv[128 + lane] * lv[192 + lane]);
      A.lam = __expf(s01) - __expf(s23) + 0.2f;
      A.kbase = 8.f * wave_max(fabsf(p.in[I_KN][lane])) * 1.01f; }
    for (int u = vcu; u < 1280; u += G) attn_unit(A, lds, u);
}
__device__ __forceinline__ void ctx_convert(const Params& p, int vcu, int G) {
    bf16* ks = (bf16*)(p.ws + X_KS); bf16* vs = (bf16*)((unsigned char*)p.out + O_VS);
    const int n = 2 * 4 * 256 * 256;
    for (int i = vcu * NTHR + threadIdx.x; i < n; i += G * NTHR) {
        const int tsr = i >> 18, rem = i & 262143, b = rem >> 16, t = (rem >> 8) & 255, c4 = rem & 255;
        const f32x4 v = *(const f32x4*)((tsr ? p.in[I_CV] : p.in[I_CK]) + ((size_t)(b * 256 + t) * 1024 + c4 * 4));
        v2u w; w.x = pk2(v.x, v.y); w.y = pk2(v.z, v.w);
        *(v2u*)((tsr ? vs : ks) + ((size_t)b * TKS + 4096 + t) * 1024 + c4 * 4) = w;
    }
}
__device__ __forceinline__ void conv_phase(const Params& p, int vcu, int G) {
    const int lane = threadIdx.x & 63, wid = threadIdx.x >> 6, gw = vcu * NWAVES + wid, NGW = G * NWAVES;
    bf16* pg = (bf16*)(p.ws + WS_PG); const float* cw = p.in[I_CONVW]; const float* cb = p.in[I_CONVB];
    for (int it = gw; it < NT * 4; it += NGW) {
        const int m = it >> 2, c0 = (it & 3) * 512 + 8 * lane;
        const int T = (m < NTP) ? TP : TS, t = (m < NTP) ? (m & 255) : ((m - NTP) & 4095);
        const v4u pc = *(const v4u*)(pg + (size_t)m * 4096 + c0), gt = *(const v4u*)(pg + (size_t)m * 4096 + 2048 + c0);
        v4u pp = {0u, 0u, 0u, 0u}, pn = {0u, 0u, 0u, 0u};
        if (t > 0) pp = *(const v4u*)(pg + (size_t)(m - 1) * 4096 + c0);
        if (t < T - 1) pn = *(const v4u*)(pg + (size_t)(m + 1) * 4096 + c0);
        v4u o;
#pragma unroll
        for (int e = 0; e < 4; ++e) { const int c = c0 + 2 * e;
            const float y0 = bflo(gt[e]) * (cw[c] * bflo(pp[e]) + cw[2048 + c] * bflo(pc[e]) + cw[4096 + c] * bflo(pn[e]) + cb[c]);
            const float y1 = bfhi(gt[e]) * (cw[c + 1] * bfhi(pp[e]) + cw[2048 + c + 1] * bfhi(pc[e]) + cw[4096 + c + 1] * bfhi(pn[e]) + cb[c + 1]);
            o[e] = pk2(y0, y1); }
        *(v4u*)(pg + (size_t)m * 4096 + 2048 + c0) = o;
    }
}
constexpr int N_PHASES = 13;
__global__ void __launch_bounds__(NTHR, 2) hybrid_fwd(Params p) {
    extern __shared__ __attribute__((aligned(16))) unsigned char lds_raw[];
    LAS unsigned char* lds = (LAS unsigned char*)lds_raw;
    const int tid = threadIdx.x, G = gridDim.x, bx = blockIdx.x;
    const int vcu = (G % 8 == 0) ? (bx % 8) * (G / 8) + bx / 8 : bx;
    volatile LAS unsigned* misc = (volatile LAS unsigned*)(lds + LDS_MISC);
    if (tid < 64) misc[tid] = 0u;
    __syncthreads();
    XcdBarrier bar = xcd_barrier_post((unsigned*)(p.ws + WS_CTL) + 1024, misc + 8);
    const int lo = p.ph_lo, hi = p.ph_hi;
#ifdef ONLY_PHASE
#define IN(k) ((k) == ONLY_PHASE && lo <= (k) && (k) < hi)
#else
#define IN(k) (lo <= (k) && (k) < hi)
#endif
#define SEAM(k) do { if (IN(k) && IN((k) + 1)) xcd_barrier(bar); } while (0)
    unsigned char* ws = p.ws; unsigned char* ob = (unsigned char*)p.out;
    const float* ada = (const float*)(ws + WS_ADA);

    if (IN(0)) { p0_prologue(p, lds, vcu, G); } SEAM(0);
    if (IN(1)) { weight_copies(p, lds, vcu, G); h_phase(p, 0, vcu, G); } SEAM(1);
    if (IN(2)) {
        pg8::Gemm g{(const bf16*)(ws + WS_H), (const bf16*)(ws + WS_WIN), NT, 4352, 1024, 1024}; pg8::StaticOrder S; S.init(NT, 4352, 1024, G, bx);
        Epi1a E{ws, ob};
        pg8::gemm_phase<Epi1a, pg8::StaticOrder, true, true>(lds, g, S, E);
    } SEAM(2);
    if (IN(3)) { scan_phase(p, lds, vcu, G); } SEAM(3);
    if (IN(4)) { scan_fixup_phase(p, vcu, G); } SEAM(4);
    if (IN(5)) { post_scan_phase(p, vcu, G); } SEAM(5);
    if (IN(6)) {
        pg8::Gemm g{(const bf16*)(ws + WS_H), (const bf16*)(ws + WS_WIN) + (size_t)4352 * 1024, NT, 4096, 1024, 1024}; pg8::StaticOrder S; S.init(NT, 4096, 1024, G, bx);
        LAS float* tab = (LAS float*)(lds + 131072);
        for (int i = tid; i < 2048 + 128; i += NTHR) tab[i] = (i < 2048) ? ((const float*)(ws + WS_ROPE))[i] : (i < 2112 ? p.in[I_QN][i - 2048] : p.in[I_KN][i - 2112]);
        __syncthreads();
        Epi1b E{(bf16*)(ws + X_Q), (bf16*)(ws + X_KP), (bf16*)(ob + O_VP), (bf16*)(ws + WS_YAB), (float*)(ob + O_NK), (float*)(ob + O_NV), tab};
        pg8::gemm_phase<Epi1b, pg8::StaticOrder, true, true>(lds, g, S, E);
        ctx_convert(p, vcu, G);
    } SEAM(6);
    if (IN(7)) { attn_phase(p, lds, vcu, G); } SEAM(7);
    if (IN(8)) {
        pg8::Gemm g{(const bf16*)(ws + WS_YAB), (const bf16*)(ws + WS_WOUT0), NT, 1024, 2048, 2048}; pg8::TailSplitOrder S; S.init(NT, 1024, 2048, G, bx);
        EpiResT<true> E{p.in[I_XP], p.in[I_XS] - (size_t)NTP * 1024, nullptr, (bf16*)(ws + WS_X1B), ada,
            (float*)(ws + WS_X), (unsigned*)(ws + WS_CTL) + CW_SPLIT};
        pg8::gemm_phase<EpiResT<true>, pg8::TailSplitOrder, true, true>(lds, g, S, E);
        if (S.split) { LAS float* scr = (LAS float*)(lds + 32768); __syncthreads(); for (int it = vcu; it < 128 * 16; it += G) conv_tile<2>(p.in[I_OWIN], 1024, 8192, (bf16*)(ws + WS_WIN), it, scr); }
        else { const int nsec = 320 - G; if (nsec >= 0 && nsec < G && bx >= nsec) { LAS float* scr = (LAS float*)(lds + 32768); __syncthreads();
            for (int it = bx - nsec; it < 128 * 16; it += G - nsec) conv_tile<2>(p.in[I_OWIN], 1024, 8192, (bf16*)(ws + WS_WIN), it, scr); }
          else if (!(nsec >= 0 && nsec < G)) { LAS float* scr = (LAS float*)(lds + 32768); __syncthreads(); for (int it = vcu; it < 128 * 16; it += G) conv_tile<2>(p.in[I_OWIN], 1024, 8192, (bf16*)(ws + WS_WIN), it, scr); } }
    } SEAM(8);
    if (IN(9)) {
        h_phase(p, 1, vcu, G);
    } SEAM(9);
    if (IN(10)) {
        pg8::Gemm g{(const bf16*)(ws + WS_H), (const bf16*)(ws + WS_WIN), NT, 8192, 1024, 1024}; pg8::StaticOrder S; S.init(NT, 8192, 1024, G, bx);
        EpiGateConv E{(bf16*)(ws + WS_YAB), (float*)(ws + WS_CSB), p.in[I_CONVW], p.in[I_CONVB], (LAS float*)(lds + 131072)};
        pg8::gemm_phase<EpiGateConv, pg8::StaticOrder, true, true>(lds, g, S, E);
    } SEAM(10);
    if (IN(11)) { conv_fix_phase(p, vcu, G); } SEAM(11);
    if (IN(12)) {
        pg8::Gemm g{(const bf16*)(ws + WS_YAB), (const bf16*)(ws + WS_WOUT1), NT, 1024, 2048, 2048}; pg8::TailSplitOrder S; S.init(NT, 1024, 2048, G, bx);
        EpiResT<false> E{nullptr, nullptr, p.out, (bf16*)(ws + WS_X1B), ada + 5 * 3072, (float*)(ws + WS_WIN), (unsigned*)(ws + WS_CTL) + CW_SPLIT + 2048};
        pg8::gemm_phase<EpiResT<false>, pg8::TailSplitOrder, true, true>(lds, g, S, E);
    }
#undef IN
#undef SEAM
}

#ifndef MK_N_LAUNCHES
#define MK_N_LAUNCHES 1
#endif
extern "C" void kernel_launch(void* const* d_in, const int* in_sizes, int n_in, void* d_out, int out_size, void* d_ws, size_t ws_size, hipStream_t stream) {
    static int grid = 0;
    if (grid == 0) {
        int dev = 0, cus = 0;
        if (n_in != 31 || ws_size < 256 * MiB || hipGetDevice(&dev) != hipSuccess || hipDeviceGetAttribute(&cus, hipDeviceAttributeMultiprocessorCount, dev) != hipSuccess) { fprintf(stderr, "kernel_launch: unexpected arguments / device (n_in %d, ws %zu)\n", n_in, ws_size); grid = -1; return; }
        if (hipFuncSetAttribute((const void*)hybrid_fwd, hipFuncAttributeMaxDynamicSharedMemorySize, LDS_BYTES) != hipSuccess) { fprintf(stderr, "kernel_launch: hipFuncSetAttribute failed\n"); grid = -1; return; }
        int per_cu = 0;
        if (hipOccupancyMaxActiveBlocksPerMultiprocessor(&per_cu, (const void*)hybrid_fwd, NTHR, LDS_BYTES) != hipSuccess || per_cu < 1) fprintf(stderr, "kernel_launch: occupancy query reports %d blocks per CU\n", per_cu);
        (void)hipGetLastError();
        grid = cus;
    }
    if (grid < 0) return;
    Params p{};
    for (int i = 0; i < 31; ++i) p.in[i] = (const float*)d_in[i];
    p.out = (float*)d_out; p.ws = (unsigned char*)d_ws;
    (void)hipMemsetAsync((char*)d_ws + WS_CTL, 0, CTL_ZERO_BYTES, stream);
    if (MK_N_LAUNCHES == 1) {
        p.ph_lo = 0; p.ph_hi = N_PHASES;
        hipLaunchKernelGGL(hybrid_fwd, dim3(grid), dim3(NTHR), LDS_BYTES, stream, p);
    } else {
        for (int k = 0; k < N_PHASES; ++k) { p.ph_lo = k; p.ph_hi = k + 1;
            hipLaunchKernelGGL(hybrid_fwd, dim3(grid), dim3(NTHR), LDS_BYTES, stream, p);
        }
    }
    const hipError_t le = hipPeekAtLastError();
    if (le != hipSuccess) fprintf(stderr, "kernel_launch: launch failed: %s\n", hipGetErrorName(le));
}
```

```cpp
#include <hip/hip_runtime.h>
#include <cstdio>
#include <cstdint>
namespace pg8 {
#define PG8_LAS __attribute__((address_space(3)))
typedef unsigned short bf16_t;
typedef short bf16x8 __attribute__((ext_vector_type(8)));
typedef float f32x4 __attribute__((ext_vector_type(4)));
typedef unsigned u32x4 __attribute__((ext_vector_type(4)));
constexpr int BM = 256, BK = 64, HALF = 128, HTB = HALF * BK * 2  , STAGE_BYTES = 8 * HTB, NXCD = 8, WGM = 8;

__host__ __device__ __forceinline__ int lds_byte(int r, int c) { const int st = (r >> 4) * 2 + (c >> 5), rr = r & 15, cc = c & 31, ob = rr * 64 + cc * 2; return st * 1024 + (ob ^ (((ob >> 9) & 1) << 5)); }
__host__ __device__ __forceinline__ void stage_rc(int b, int& R, int& C) { const int st = b / 1024, sb = b % 1024, swz = sb ^ (((sb >> 9) & 1) << 5); R = (st >> 1) * 16 + swz / 64; C = (st & 1) * 32 + (swz % 64) / 2; }
__host__ __device__ __forceinline__ int perm32(int rho) { const int n = rho >> 4, i = rho & 15; return 8 * (i >> 2) + 4 * n + (i & 3); }

struct Unit { int pm, pn, k0, nt, part, tix; };
struct Gemm { const bf16_t* A; const bf16_t* Bt; int M, N, K, lda; };

struct StaticOrder {
    int nM, nN, nwg, G, c, ntk;
    __host__ __device__ void init(int M, int N, int K, int G_, int c_) { nM = M / BM; nN = N / BM; nwg = nM * nN; G = G_; c = c_; ntk = K / BK; }
    __host__ __device__ bool tile(long L, Unit& u) const {
        if (L >= nwg) return false;
        int wgid = (int)L; { const int q = nwg / NXCD, r = nwg % NXCD, xcd = wgid % NXCD, off = wgid / NXCD; wgid = (xcd < r ? xcd * (q + 1) : r * (q + 1) + (xcd - r) * q) + off; }
        const int nig = WGM * nN, gid = wgid / nig, fm = gid * WGM, gsz = (nM - fm) < WGM ? (nM - fm) : WGM;
        u.pm = fm + ((wgid % nig) % gsz); u.pn = (wgid % nig) / gsz; u.k0 = 0; u.nt = ntk; u.part = -1; u.tix = 0; return true;
    }
    __host__ __device__ bool next(int i, Unit& u) const { return tile((long)i * G + c, u); }
    __device__ __forceinline__ void a_ready(const Unit&) const {}
    __device__ __forceinline__ void done(const Unit&) const {}
};
struct TailSplitOrder {
    StaticOrder s; int split;
    __host__ __device__ void init(int M, int N, int K, int G_, int c_) { s.init(M, N, K, G_, c_); split = (s.nwg > G_ && 4 * (s.nwg - G_) == G_ && (s.ntk % 8) == 0) ? 1 : 0; }
    __host__ __device__ bool next(int i, Unit& u) const {
        if (!split || i == 0) return s.next(i, u);
        if (i > 1) return false;
        int j, t; if (s.G % 32 == 0) { const int x = s.c & 7, r = s.c >> 3; j = r & 3; t = (r >> 2) * 8 + x; } else { j = s.c & 3; t = s.c >> 2; }
        if (!s.tile((long)s.G + t, u)) return false;
        u.nt = s.ntk / 4; u.k0 = j * u.nt; u.part = j; u.tix = t; return true;
    }
    __device__ __forceinline__ void a_ready(const Unit&) const {}
    __device__ __forceinline__ void done(const Unit&) const {}
};


template <class Epi, class Sched, bool ALIGN_EPI = false, bool SP2 = false>
__device__ __forceinline__ void gemm_phase(PG8_LAS unsigned char* lds, const Gemm g, const Sched& S, const Epi& E) {
    const int tid = threadIdx.x, wid = __builtin_amdgcn_readfirstlane(tid >> 6), lane = tid & 63, wr = wid >> 2, wc = wid & 3, fr = lane & 15, fq = lane >> 4;
    const int K = g.K;
    unsigned voffA[2], voffB[2];
#pragma unroll
    for (int i = 0; i < 2; ++i) { int R, C; stage_rc(tid * 16 + i * 8192, R, C); const int Rb = Epi::PERM ? ((R & ~31) + perm32(R & 31)) : R;
        voffA[i] = (unsigned)(R * g.lda + C) * 2u; voffB[i] = (unsigned)(Rb * K + C) * 2u; }
    const size_t kstep = (size_t)(BK * 2);
    const size_t hstep = (size_t)HALF * K * 2;
    const size_t hstepA = (size_t)HALF * g.lda * 2, tstepA = 2 * hstepA;
    const size_t tstep = 2 * hstep;
    const unsigned ldsw = (unsigned)wid * 1024u;
    const int aoff = lds_byte(wr * 64 + fr, fq * 8), boff = lds_byte(wc * 32 + fr, fq * 8);
#define PG8_SA(b, h) (((b) * 2 + (h)) * HTB)
#define PG8_SB(b, h) ((4 + (b) * 2 + (h)) * HTB)
#define PG8_STAGE(bufoff, gbase, voff) do { _Pragma("unroll") for (int _i = 0; _i < 2; ++_i) \
        __builtin_amdgcn_global_load_lds((const unsigned*)((const char*)(gbase) + (voff)[_i]), (PG8_LAS unsigned*)(lds + (bufoff) + ldsw + _i * 8192), 16, 0, 0); } while (0)
#define PG8_LDA(dst, b, h) do { _Pragma("unroll") for (int m = 0; m < 4; ++m) _Pragma("unroll") for (int k = 0; k < 2; ++k) dst[m][k] = *(const PG8_LAS bf16x8*)(lds + PG8_SA(b, h) + aoff + m * 2048 + k * 1024); } while (0)
#define PG8_LDB(dst, b, h) do { _Pragma("unroll") for (int n = 0; n < 2; ++n) _Pragma("unroll") for (int k = 0; k < 2; ++k) dst[n][k] = *(const PG8_LAS bf16x8*)(lds + PG8_SB(b, h) + boff + n * 2048 + k * 1024); } while (0)
#define PG8_MMA(ai, bj, At, Bt) do { __builtin_amdgcn_s_setprio(1); _Pragma("unroll") for (int m = 0; m < 4; ++m) _Pragma("unroll") for (int n = 0; n < 2; ++n) _Pragma("unroll") for (int k = 0; k < 2; ++k) \
        acc[ai][bj][m][n] = __builtin_amdgcn_mfma_f32_16x16x32_bf16(Bt[n][k], At[m][k], acc[ai][bj][m][n], 0, 0, 0); __builtin_amdgcn_s_setprio(0); } while (0)
#define PG8_WAIT_V(n) asm volatile("s_waitcnt vmcnt(" #n ")" ::: "memory")
#define PG8_WAIT_L(n) asm volatile("s_waitcnt lgkmcnt(" #n ")" ::: "memory")
#define PG8_BAR __builtin_amdgcn_s_barrier()
#define PG8_SCHED __builtin_amdgcn_sched_barrier(0)
    Unit cur, nxt; int ui = 0;
    if (!S.next(0, cur)) return;
    f32x4 acc[2][2][4][2];
#pragma unroll
    for (int a = 0; a < 2; ++a)
#pragma unroll
        for (int b = 0; b < 2; ++b)
#pragma unroll
            for (int m = 0; m < 4; ++m)
#pragma unroll
                for (int n = 0; n < 2; ++n) acc[a][b][m][n] = (f32x4){0.f, 0.f, 0.f, 0.f};
    bf16x8 At[4][2], B0[2][2], B1[2][2];
    const char* cA = (const char*)g.A + (size_t)cur.pm * tstepA + (size_t)cur.k0 * kstep; const char* cB = (const char*)g.Bt + (size_t)cur.pn * tstep + (size_t)cur.k0 * kstep;
    S.a_ready(cur);
    if constexpr (SP2) {
        PG8_STAGE(PG8_SB(0, 0), cB, voffB); PG8_STAGE(PG8_SB(0, 1), cB + hstep, voffB); PG8_STAGE(PG8_SA(0, 0), cA, voffA); PG8_STAGE(PG8_SA(0, 1), cA + hstepA, voffA);
        if (wr == 1) PG8_BAR;
        PG8_WAIT_V(2); PG8_BAR;
        PG8_STAGE(PG8_SB(1, 0), cB + kstep, voffB); PG8_STAGE(PG8_SA(1, 0), cA + kstep, voffA); PG8_STAGE(PG8_SB(1, 1), cB + hstep + kstep, voffB);
        PG8_WAIT_V(6); PG8_BAR;
    } else {
        PG8_STAGE(PG8_SB(0, 0), cB, voffB); PG8_STAGE(PG8_SA(0, 0), cA, voffA); PG8_STAGE(PG8_SB(0, 1), cB + hstep, voffB); PG8_STAGE(PG8_SA(0, 1), cA + hstepA, voffA);
        if (wr == 1) PG8_BAR;
        PG8_WAIT_V(4); PG8_BAR;
        PG8_STAGE(PG8_SB(1, 0), cB + kstep, voffB); PG8_STAGE(PG8_SA(1, 0), cA + kstep, voffA); PG8_STAGE(PG8_SB(1, 1), cB + hstep + kstep, voffB);
        PG8_WAIT_V(6); PG8_BAR;
    }
    for (;;) {
        const bool has_next = S.next(ui + 1, nxt);
        const char* nA = has_next ? (const char*)g.A + (size_t)nxt.pm * tstepA + (size_t)nxt.k0 * kstep : cA; const char* nB = has_next ? (const char*)g.Bt + (size_t)nxt.pn * tstep + (size_t)nxt.k0 * kstep : cB;
        const int nt = cur.nt;
        for (int t = 0; t < nt; t += 2) {
            const bool last = (t == nt - 2);
            const char* a1 = cA + (size_t)(t + 1) * kstep;
            const char* a2 = last ? nA : cA + (size_t)(t + 2) * kstep; const char* b2 = last ? nB : cB + (size_t)(t + 2) * kstep;
            const char* a3 = a2 + kstep; const char* b3 = b2 + kstep;
            if (last && has_next) S.a_ready(nxt);
            if constexpr (SP2) {
            PG8_LDB(B0, 0, 0); PG8_LDB(B1, 0, 1); PG8_SCHED; PG8_LDA(At, 0, 0); PG8_STAGE(PG8_SA(1, 1), a1 + hstepA, voffA);
            PG8_WAIT_V(8); PG8_WAIT_L(0); PG8_BAR; PG8_MMA(0, 0, At, B0); PG8_MMA(0, 1, At, B1); PG8_BAR; PG8_SCHED;
            PG8_LDA(At, 0, 1); PG8_STAGE(PG8_SB(0, 0), b2, voffB); PG8_STAGE(PG8_SB(0, 1), b2 + hstep, voffB); PG8_STAGE(PG8_SA(0, 0), a2, voffA);
            PG8_WAIT_V(8); PG8_WAIT_L(0); PG8_BAR; PG8_MMA(1, 0, At, B0); PG8_MMA(1, 1, At, B1); PG8_BAR; PG8_SCHED;
            PG8_LDB(B0, 1, 0); PG8_LDB(B1, 1, 1); PG8_SCHED; PG8_LDA(At, 1, 0); PG8_STAGE(PG8_SA(0, 1), a2 + hstepA, voffA);
            PG8_WAIT_V(8); PG8_WAIT_L(0); PG8_BAR; PG8_MMA(0, 0, At, B0); PG8_MMA(0, 1, At, B1); PG8_BAR; PG8_SCHED;
            PG8_LDA(At, 1, 1); PG8_STAGE(PG8_SB(1, 0), b3, voffB); PG8_STAGE(PG8_SB(1, 1), b3 + hstep, voffB); PG8_STAGE(PG8_SA(1, 0), a3, voffA);
            PG8_WAIT_V(8); PG8_WAIT_L(0); PG8_BAR; PG8_MMA(1, 0, At, B0); PG8_MMA(1, 1, At, B1); PG8_BAR; PG8_SCHED;
            } else {
            PG8_LDB(B0, 0, 0); PG8_SCHED; PG8_LDA(At, 0, 0); PG8_STAGE(PG8_SA(1, 1), a1 + hstepA, voffA);
            PG8_WAIT_L(8); PG8_BAR; PG8_WAIT_L(0); PG8_MMA(0, 0, At, B0); PG8_BAR; PG8_SCHED;
            PG8_LDB(B1, 0, 1); PG8_STAGE(PG8_SB(0, 0), b2, voffB);
            PG8_BAR; PG8_WAIT_L(0); PG8_MMA(0, 1, At, B1); PG8_BAR;
            PG8_LDA(At, 0, 1); PG8_STAGE(PG8_SA(0, 0), a2, voffA);
            PG8_BAR; PG8_WAIT_L(0); PG8_MMA(1, 0, At, B0); PG8_BAR; PG8_SCHED;
            PG8_STAGE(PG8_SB(0, 1), b2 + hstep, voffB);
            PG8_WAIT_V(6); PG8_BAR; PG8_MMA(1, 1, At, B1); PG8_BAR;
            PG8_LDB(B0, 1, 0); PG8_SCHED; PG8_LDA(At, 1, 0); PG8_STAGE(PG8_SA(0, 1), a2 + hstepA, voffA);
            PG8_WAIT_L(8); PG8_BAR; PG8_WAIT_L(0); PG8_MMA(0, 0, At, B0); PG8_BAR; PG8_SCHED;
            PG8_LDB(B1, 1, 1); PG8_STAGE(PG8_SB(1, 0), b3, voffB);
            PG8_BAR; PG8_WAIT_L(0); PG8_MMA(0, 1, At, B1); PG8_BAR;
            PG8_LDA(At, 1, 1); PG8_STAGE(PG8_SA(1, 0), a3, voffA);
            PG8_BAR; PG8_WAIT_L(0); PG8_MMA(1, 0, At, B0); PG8_BAR; PG8_SCHED;
            PG8_STAGE(PG8_SB(1, 1), b3 + hstep, voffB);
            PG8_WAIT_V(6); PG8_BAR; PG8_MMA(1, 1, At, B1); PG8_BAR;
            }
        }
        if constexpr (ALIGN_EPI) { if (wr == 0) PG8_BAR; }
        if constexpr (!Epi::AFTER_DRAIN) { E(acc, cur, wr, wc, fr, fq); S.done(cur); }
        if (!has_next) break;
#pragma unroll
        for (int a = 0; a < 2; ++a)
#pragma unroll
            for (int b = 0; b < 2; ++b)
#pragma unroll
                for (int m = 0; m < 4; ++m)
#pragma unroll
                    for (int n = 0; n < 2; ++n) acc[a][b][m][n] = (f32x4){0.f, 0.f, 0.f, 0.f};
        cur = nxt; cA = nA; cB = nB; ++ui;
        if constexpr (ALIGN_EPI) { if (wr == 1) PG8_BAR; }
    }
    PG8_WAIT_V(0);
    if constexpr (!ALIGN_EPI) { if (wr == 0) PG8_BAR; }
    PG8_BAR;
    if constexpr (Epi::AFTER_DRAIN) { E.fused(acc, cur, wr, wc, fr, fq, lds, wid, lane); S.done(cur); }
#undef PG8_SA
#undef PG8_SB
#undef PG8_STAGE
#undef PG8_LDA
#undef PG8_LDB
#undef PG8_MMA
#undef PG8_WAIT_V
#undef PG8_WAIT_L
#undef PG8_BAR
#undef PG8_SCHED
}
}
#define GAS __attribute__((address_space(1)))
#define LAS __attribute__((address_space(3)))
typedef unsigned short bf16;
typedef unsigned v4u __attribute__((ext_vector_type(4)));
typedef unsigned v2u __attribute__((ext_vector_type(2)));
typedef float f32x4 __attribute__((ext_vector_type(4)));
typedef float f32x16 __attribute__((ext_vector_type(16)));
typedef short bf16x8 __attribute__((ext_vector_type(8)));
typedef short s16x4 __attribute__((ext_vector_type(4)));
typedef _Float16 h8 __attribute__((ext_vector_type(8)));

constexpr int NWAVES = 8, NTHR = 512;
constexpr int D = 1024, NTP = 4096, NTS = 16384, NT = 20480;
constexpr int TP = 256, TS = 4096, TKS = 4352;
constexpr size_t MiB = 1u << 20;
constexpr size_t WS_CTL = 0, CTL_ZERO_BYTES = 65536;
constexpr int CW_SPLIT = 8192;
constexpr size_t WS_ADA = 65536;
constexpr size_t WS_ROPE = 196608;
constexpr size_t WS_KMAX = 204800;
constexpr size_t WS_WUPT = 262144;
constexpr size_t WS_BN = 786432;
constexpr size_t WS_WOUT1 = 4 * MiB;
constexpr size_t WS_WIN = 8 * MiB;
constexpr size_t WS_WOUT0 = 25 * MiB;
constexpr size_t WS_H = 29 * MiB;
constexpr size_t WS_YAB = 69 * MiB;
constexpr size_t WS_X = 149 * MiB;
constexpr size_t WS_X1B = WS_X + 24 * MiB;
constexpr size_t WS_CSB = WS_X + 64 * MiB;
constexpr size_t X_PAR = WS_X, X_PAK = WS_X + 40 * MiB, X_PAL = WS_X + 80 * MiB, X_OFP = WS_X + 90 * MiB, X_SMID = WS_X + 98 * MiB;
constexpr size_t X_Q = WS_X, X_KP = WS_X + 40 * MiB, X_KS = WS_X + 48 * MiB;
constexpr size_t WS_PG = WS_YAB;
static_assert(WS_BN + (size_t)NT * 32 * 4 <= WS_WOUT1 && WS_WIN + (size_t)8448 * 1024 * 2 <= WS_WOUT0 && X_OFP + 8 * MiB <= 256 * MiB && X_KS + 34 * MiB <= 256 * MiB && WS_PG + 160 * MiB <= 256 * MiB, "ws map");
constexpr size_t O_Y = 0, O_SF = 80 * MiB, O_SB = 84 * MiB, O_NK = 88 * MiB, O_NV = 104 * MiB;
constexpr size_t O_PAV = 0, O_OB = 40 * MiB, O_OFS = 88 * MiB;
constexpr size_t O_VP = 0, O_VS = 8 * MiB;
constexpr int LDS_BYTES = 147456, LDS_MISC = 147200;

__device__ __forceinline__ unsigned f2bf(float f) { unsigned u = __builtin_bit_cast(unsigned, f); return (u + 0x7fffu + ((u >> 16) & 1u)) >> 16; }
__device__ __forceinline__ unsigned pk2(float lo, float hi) { return f2bf(lo) | (f2bf(hi) << 16); }
__device__ __forceinline__ float bf2f(unsigned h) { return __builtin_bit_cast(float, h << 16); }
__device__ __forceinline__ float bflo(unsigned w) { return __builtin_bit_cast(float, w << 16); }
__device__ __forceinline__ float bfhi(unsigned w) { return __builtin_bit_cast(float, w & 0xffff0000u); }
__device__ __forceinline__ float frcp(float x) { return __builtin_amdgcn_rcpf(x); }
__device__ __forceinline__ float siluf(float x) { return x * frcp(1.f + __expf(-x)); }
__device__ __forceinline__ float sigmf(float x) { return frcp(1.f + __expf(-x)); }
__device__ __forceinline__ float wave_sum(float v) {
#pragma unroll
    for (int o = 1; o < 64; o <<= 1) v += __shfl_xor(v, o);
    return v;
}
__device__ __forceinline__ float wave_max(float v) {
#pragma unroll
    for (int o = 1; o < 64; o <<= 1) v = fmaxf(v, __shfl_xor(v, o));
    return v;
}
template <int CTRL> __device__ __forceinline__ float dppf(float x) { return __builtin_bit_cast(float, __builtin_amdgcn_update_dpp(0, __builtin_bit_cast(int, x), CTRL, 0xf, 0xf, true)); }
__device__ __forceinline__ float sum8(float x) { x += dppf<0xB1>(x); x += dppf<0x4E>(x); x += dppf<0x141>(x); return x; }
__device__ __forceinline__ float sum16(float x) { x = sum8(x); x += dppf<0x140>(x); return x; }

__device__ __forceinline__ void glds16(const void* gsrc, unsigned lds_dst) { unsigned keep;
    asm volatile("s_mov_b32 %0, m0\n\ts_mov_b32 m0, %2\n\ts_nop 0\n\tglobal_load_lds_dwordx4 %1, off\n\ts_mov_b32 m0, %0" : "=&s"(keep) : "v"(gsrc), "s"(lds_dst) : "memory"); }

struct Params {
    const float* in[31];
    float* out;
    unsigned char* ws;
    int ph_lo, ph_hi;
};
enum { I_XP = 0, I_XS, I_SF, I_SB, I_CK, I_CV, I_C, I_CCTX, I_NW, I_ADAW, I_ADAB, I_EWIN, I_EWOUT, I_MU, I_W0, I_WUP, I_A0, I_AUP, I_KK, I_KA, I_RK, I_LNW, I_LNB,
       I_QN, I_KN, I_LAM, I_SUBLN, I_OWIN, I_CONVW, I_CONVB, I_OWOUT };
#define XB_TMO      128
#define XB_XCNT(j)  (256  + 64 * (j))
#define XB_XSUB(j)  (1280 + 64 * (j))
#define XB_XGEN(j)  (2304 + 64 * (j))
#define XB_TOP      3328
#define XB_TOPGEN   3392
#define XCD_BAR_WORDS 3456
#define XB_SPIN_CAP (1u << 18)

__device__ __forceinline__ unsigned xb_ld(unsigned* p)              { return __hip_atomic_load(p, __ATOMIC_RELAXED, __HIP_MEMORY_SCOPE_AGENT); }
__device__ __forceinline__ unsigned xb_add(unsigned* p, unsigned v) { return __hip_atomic_fetch_add(p, v, __ATOMIC_RELAXED, __HIP_MEMORY_SCOPE_AGENT); }
__device__ __forceinline__ unsigned xb_xcc_id() { return (unsigned)__builtin_amdgcn_s_getreg((3 << 11) | 20) & 0xFu; }
#define XB_SPIN(cond, bar) do { unsigned _sp = 0; while (cond) { __builtin_amdgcn_s_sleep(1); \
    if ((++_sp & 255u) == 0u) { if (xb_ld(&(bar)[XB_TMO])) break; if (_sp > XB_SPIN_CAP) { atomicAdd(&(bar)[XB_TMO], 1u); break; } } } } while (0)

struct XcdBarrier {
    unsigned* bar; unsigned x;
    volatile LAS unsigned* st;
};

__device__ __forceinline__ XcdBarrier xcd_barrier_post(unsigned* bar, volatile LAS unsigned* st) {
    XcdBarrier b; b.bar = bar; b.x = xb_xcc_id(); b.st = st;
    if (threadIdx.x == 0) (void)xb_add(&bar[XB_XCNT(b.x)], 1u);
    return b;
}
__device__ __forceinline__ void xcd_barrier_complete(unsigned* bar, unsigned x, unsigned& nloc, unsigned& nx) {
    const unsigned G = gridDim.x * gridDim.y * gridDim.z;
    unsigned sum, cnt, mine, sp = 0u;
    for (;;) {
        sum = 0u; cnt = 0u; mine = 0u;
#pragma unroll
        for (unsigned j = 0; j < 16; ++j) { const unsigned c = xb_ld(&bar[XB_XCNT(j)]); sum += c; cnt += (c > 0u) ? 1u : 0u; mine = (j == x) ? c : mine; }
        if (sum == G) break;
        __builtin_amdgcn_s_sleep(1);
        if ((++sp & 255u) == 0u) { if (xb_ld(&bar[XB_TMO])) break; if (sp > XB_SPIN_CAP) { atomicAdd(&bar[XB_TMO], 1u); break; } }
    }
    nloc = mine > 0u ? mine : 1u; nx = cnt > 0u ? cnt : 1u;
}

__device__ __forceinline__ void xcd_barrier(const XcdBarrier& b) {
    asm volatile("s_waitcnt vmcnt(0)" ::: "memory");
    __syncthreads();
    if (threadIdx.x == 0) {
        unsigned* bar = b.bar;
        __builtin_amdgcn_s_waitcnt(0);
        unsigned nloc = b.st[0], nx = b.st[1];
        if (nloc == 0u) { xcd_barrier_complete(bar, b.x, nloc, nx); b.st[0] = nloc; b.st[1] = nx; }
        const unsigned old = xb_add(&bar[XB_XSUB(b.x)], 1u);
        const unsigned gen = old / nloc;
        if (old + 1u == (gen + 1u) * nloc) {
            __builtin_amdgcn_fence(__ATOMIC_RELEASE, "agent");
            asm volatile("s_waitcnt vmcnt(0)" ::: "memory");
            const unsigned og = xb_add(&bar[XB_TOP], 1u);
            const unsigned tg = og / nx;
            if (og + 1u == (tg + 1u) * nx) xb_add(&bar[XB_TOPGEN], 1u);
            else XB_SPIN(xb_ld(&bar[XB_TOPGEN]) == tg, bar);
            __builtin_amdgcn_fence(__ATOMIC_ACQUIRE, "agent");
            xb_add(&bar[XB_XGEN(b.x)], 1u);
            asm volatile("s_waitcnt vmcnt(0)" ::: "memory");
        } else {
            XB_SPIN(xb_ld(&bar[XB_XGEN(b.x)]) == gen, bar);
            __builtin_amdgcn_fence(__ATOMIC_ACQUIRE, "agent");
            asm volatile("s_waitcnt vmcnt(0)" ::: "memory");
        }
    }
    __syncthreads();
}

__device__ __forceinline__ int perm32d(int rho) { const int n = rho >> 4, i = rho & 15; return 8 * (i >> 2) + 4 * n + (i & 3); }
template <int MAP> __device__ __forceinline__ int srccol(int np) {
    if (MAP == 0) return np;
    if (MAP == 1) {
        if (np < 4352) return (np & ~31) + perm32d(np & 31);
        const int m = np - 4352, tile = m >> 8, rho = m & 255;
        if (tile < 8) { const int bj = rho >> 7, wc = (rho >> 5) & 3, r32 = rho & 31; return 4352 + tile * 256 + 64 * wc + 32 * bj + r32; }
        return 4352 + (m & ~31) + perm32d(m & 31);
    }
    { const int T = np >> 8, rho = np & 255, bj = rho >> 7, wc = (rho >> 5) & 3, n = (rho >> 4) & 1, i = rho & 15; return (2 * bj + n) * 2048 + 64 * T + 16 * wc + i; }
}
template <int MAP> __device__ __forceinline__ void conv_tiles(const float* src, int K, int N, bf16* dst, int first, int end, int step, LAS float* scr) {
    const int tid = threadIdx.x, nkt = K / 64;
    float r[8], rn[8];
#define CT_LOAD(dst_, tile_) do { const int nt_ = (tile_) / nkt, kt_ = (tile_) % nkt; const int sc_ = srccol<MAP>(nt_ * 64 + (tid & 63)); const float* s_ = src + (size_t)(kt_ * 64 + (tid >> 6)) * N + sc_; \
        _Pragma("unroll") for (int i = 0; i < 8; ++i) dst_[i] = s_[(size_t)(8 * i) * N]; } while (0)
    if (first < end) CT_LOAD(r, first);
    for (int tile = first; tile < end; tile += step) {
        const int nt = tile / nkt, kt = tile % nkt, n0 = nt * 64, k0 = kt * 64;
        { const int nn = tid & 63, kq = tid >> 6;
#pragma unroll
          for (int i = 0; i < 8; ++i) scr[(kq + 8 * i) * 65 + nn] = r[i]; }
        if (tile + step < end) CT_LOAD(rn, tile + step);
        __syncthreads();
        { const int nn = tid >> 3, kc = tid & 7; const LAS float* s = scr + (8 * kc) * 65 + nn;
          v4u o; o.x = pk2(s[0], s[65]); o.y = pk2(s[2 * 65], s[3 * 65]); o.z = pk2(s[4 * 65], s[5 * 65]); o.w = pk2(s[6 * 65], s[7 * 65]);
          *(v4u*)(dst + (size_t)(n0 + nn) * K + k0 + 8 * kc) = o; }
        __syncthreads();
#pragma unroll
        for (int i = 0; i < 8; ++i) r[i] = rn[i];
    }
#undef CT_LOAD
}
__device__ __forceinline__ void ada_item(const Params& p, int item, const LAS float* sc, LAS float* red) {
    const int tid = threadIdx.x, L = item / 96, col0 = (item % 96) * 32, cl = tid & 31, kg = tid >> 5;
    const float* w = p.in[I_ADAW] + ((size_t)L * 1024 + kg * 64) * 3072 + col0 + cl;
    float a0 = 0.f, a1 = 0.f, a2 = 0.f, a3 = 0.f, a4 = 0.f;
#pragma unroll 8
    for (int kk = 0; kk < 64; ++kk) { const float wv = w[(size_t)kk * 3072]; const int k = kg * 64 + kk;
        a0 += sc[k] * wv; a1 += sc[1024 + k] * wv; a2 += sc[2048 + k] * wv; a3 += sc[3072 + k] * wv; a4 += sc[4096 + k] * wv; }
    red[(kg * 5 + 0) * 32 + cl] = a0; red[(kg * 5 + 1) * 32 + cl] = a1; red[(kg * 5 + 2) * 32 + cl] = a2; red[(kg * 5 + 3) * 32 + cl] = a3; red[(kg * 5 + 4) * 32 + cl] = a4;
    __syncthreads();
    if (tid < 160) { const int v = tid >> 5; float s = p.in[I_ADAB][L * 3072 + col0 + cl];
#pragma unroll
        for (int g = 0; g < 16; ++g) s += red[(g * 5 + v) * 32 + cl];
        ((float*)(p.ws + WS_ADA))[(L * 5 + v) * 3072 + col0 + cl] = s; }
    __syncthreads();
}
__device__ __forceinline__ void p0_prologue(const Params& p, LAS unsigned char* lds, int vcu, int G) {
    const int tid = threadIdx.x, lane = tid & 63, wid = tid >> 6;
    LAS float* sc = (LAS float*)lds;
    LAS float* red = (LAS float*)(lds + 20480);
    LAS float* scr = (LAS float*)(lds + 32768);
    constexpr int N_ADA = 192, N_UP = 64, N_ROPE = 1, N_KMAX = 8;
    constexpr int NITEMS = N_ADA + N_UP + N_ROPE + N_KMAX;
    if (vcu < N_ADA) {
        for (int i = tid; i < 5 * 1024; i += NTHR) { const int v = i >> 10, k = i & 1023; const float x = (v == 0) ? p.in[I_CCTX][k] : p.in[I_C][(v - 1) * 1024 + k]; sc[i] = siluf(x); }
        __syncthreads();
    }
    for (int it = vcu; it < NITEMS; it += G) {
        int r = it;
        if (r < N_ADA) { ada_item(p, r, sc, red); continue; } r -= N_ADA;
        if (r < N_UP) { const int md = r >> 4, tl = r & 15;
            const float* src = ((md >> 1) ? p.in[I_AUP] : p.in[I_WUP]) + (size_t)(md & 1) * 64 * 1024;
            conv_tiles<0>(src, 64, 1024, (bf16*)(p.ws + WS_WUPT) + (size_t)md * 65536, tl, tl + 1, 1, scr); continue; } r -= N_UP;
        if (r < N_ROPE) { float* rt = (float*)(p.ws + WS_ROPE);
            for (int i = tid; i < 1024; i += NTHR) { const int pos = i >> 4, f = i & 15; const float inv = powf(10000.f, -(float)f / 16.f); const float ang = (float)pos * inv; rt[pos * 32 + f] = cosf(ang); rt[pos * 32 + 16 + f] = sinf(ang); }
            continue; } r -= N_ROPE;
        { const int gi = r * 8 + wid, b = gi >> 4, hc = gi & 15;
          float mx = 0.f;
          for (int q = 0; q < 4; ++q) { const int t = lane + 64 * q; const f32x4* kp = (const f32x4*)(p.in[I_CK] + ((size_t)(b * 256 + t) * 16 + hc) * 64); float ss = 0.f;
#pragma unroll
              for (int j = 0; j < 16; ++j) { const f32x4 v = kp[j]; ss += v.x * v.x + v.y * v.y + v.z * v.z + v.w * v.w; }
              mx = fmaxf(mx, ss); }
          mx = wave_max(mx);
          if (lane == 0) ((float*)(p.ws + WS_KMAX))[gi] = mx; }
    }
}
__device__ __forceinline__ void weight_copies(const Params& p, LAS unsigned char* lds, int vcu, int G) {
    LAS float* scr = (LAS float*)(lds + 32768);
    constexpr int N_EIN = 132 * 16, N_EOUT = 16 * 32, N_OOUT = 16 * 32;
    conv_tiles<1>(p.in[I_EWIN], 1024, 8448, (bf16*)(p.ws + WS_WIN), vcu, N_EIN, G, scr);
    { const int f = ((vcu - N_EIN) % G + G) % G; conv_tiles<0>(p.in[I_EWOUT], 2048, 1024, (bf16*)(p.ws + WS_WOUT0), f, N_EOUT, G, scr); }
    { const int f = ((vcu - N_EIN - N_EOUT) % G + G) % G; conv_tiles<0>(p.in[I_OWOUT], 2048, 1024, (bf16*)(p.ws + WS_WOUT1), f, N_OOUT, G, scr); }
}
__device__ __forceinline__ void h_phase(const Params& p, int L, int vcu, int G) {
    const int lane = threadIdx.x & 63, wid = threadIdx.x >> 6, gw = vcu * NWAVES + wid, NGW = G * NWAVES;
    const float* nw = p.in[I_NW] + L * 1024;
    bf16* H = (bf16*)(p.ws + WS_H);
    const int per = (NT + NGW - 1) / NGW, mlo = gw * per, mhi = (mlo + per < NT) ? mlo + per : NT;
    f32x4 fa[4], fb[4]; int cur = -1;
    f32x4 rw[3][4];
#define H_LOAD(dst, mm) do { const int mm_ = (mm) < mhi ? (mm) : mhi - 1; \
        const float* xr_ = (mm_ < NTP) ? p.in[I_XP] + (size_t)mm_ * 1024 : p.in[I_XS] + (size_t)(mm_ - NTP) * 1024; const bf16* xb_ = (const bf16*)(p.ws + WS_X1B) + (size_t)mm_ * 1024; \
        _Pragma("unroll") for (int j = 0; j < 2; ++j) { if (L == 0) { dst[2 * j] = *(const f32x4*)(xr_ + 512 * j + 8 * lane); dst[2 * j + 1] = *(const f32x4*)(xr_ + 512 * j + 8 * lane + 4); } \
            else { const v4u w_ = *(const v4u*)(xb_ + 512 * j + 8 * lane); dst[2 * j] = __builtin_bit_cast(f32x4, w_); } } } while (0)
    if (mlo < mhi) { H_LOAD(rw[0], mlo); H_LOAD(rw[1], mlo + 1); }
    for (int m0 = mlo; m0 < mhi; m0 += 3) {
#pragma unroll
      for (int u = 0; u < 3; ++u) { const int m = m0 + u; if (m >= mhi) break;
        H_LOAD(rw[(u + 2) % 3], m + 2);
        const int vec = (m < NTP) ? 0 : 1 + ((m - NTP) >> 12);
        if (vec != cur) { cur = vec; const float* ada = (const float*)(p.ws + WS_ADA) + (size_t)(L * 5 + vec) * 3072;
#pragma unroll
            for (int q = 0; q < 4; ++q) { const int c = 512 * (q >> 1) + 8 * lane + 4 * (q & 1); fa[q] = *(const f32x4*)(nw + c) * (*(const f32x4*)(ada + 1024 + c) + 1.f); fb[q] = *(const f32x4*)(ada + c); } }
        f32x4 v[4]; float ss = 0.f;
#pragma unroll
        for (int q = 0; q < 4; ++q) {
            if (L == 0) v[q] = rw[u][q];
            else { const v4u w = __builtin_bit_cast(v4u, rw[u][2 * (q >> 1)]); const unsigned w0 = (q & 1) ? w.z : w.x, w1 = (q & 1) ? w.w : w.y; v[q] = (f32x4){bflo(w0), bfhi(w0), bflo(w1), bfhi(w1)}; }
            ss += v[q].x * v[q].x + v[q].y * v[q].y + v[q].z * v[q].z + v[q].w * v[q].w; }
        const float rstd = rsqrtf(wave_sum(ss) * (1.f / 1024.f) + 1e-6f);
#pragma unroll
        for (int j = 0; j < 2; ++j) {
            const f32x4 h0 = v[2 * j] * rstd * fa[2 * j] + fb[2 * j], h1 = v[2 * j + 1] * rstd * fa[2 * j + 1] + fb[2 * j + 1];
            v4u o; o.x = pk2(h0.x, h0.y); o.y = pk2(h0.z, h0.w); o.z = pk2(h1.x, h1.y); o.w = pk2(h1.z, h1.w);
            *(v4u*)(H + (size_t)m * 1024 + 512 * j + 8 * lane) = o; }
      }
    }
#undef H_LOAD
}
__device__ __forceinline__ f32x4 silu4(f32x4 v) { return (f32x4){siluf(v.x), siluf(v.y), siluf(v.z), siluf(v.w)}; }
__device__ __forceinline__ size_t kvrow(int m) { return (m < NTP) ? (size_t)m : (size_t)NTP + (size_t)((m - NTP) >> 12) * TKS + ((m - NTP) & 4095); }

struct Epi1a {
    static constexpr bool PERM = false, AFTER_DRAIN = false;
    unsigned char *ws, *ob;
    __device__ __forceinline__ void operator()(const pg8::f32x4 (&acc)[2][2][4][2], const pg8::Unit& u, int wr_, int wc_, int fr_, int fq_) const {
        int fr = fr_, fq = fq_, wr = wr_, wc = wc_; asm volatile("" : "+v"(fr), "+v"(fq), "+v"(wr), "+v"(wc));
        const int pn = u.pn; unsigned char* base; unsigned boff; int pitch, colt; bool act = false;
        if (pn < 4) { base = ws; boff = (unsigned)X_PAR; pitch = 1024; colt = pn * 256; }
        else if (pn < 8) { base = ws; boff = (unsigned)X_PAK; pitch = 1024; colt = (pn - 4) * 256; }
        else if (pn < 12) { base = ob; boff = (unsigned)O_PAV; pitch = 1024; colt = (pn - 8) * 256; }
        else if (pn == 12) { base = ws; boff = (unsigned)X_PAL; pitch = 256; colt = 0; }
        else { base = ws; boff = (unsigned)WS_YAB; pitch = 2048; colt = (pn - 13) * 256; act = true; }
        const int row0 = u.pm * 256 + wr * 64 + fr, col0 = colt + wc * 32 + 8 * fq;
#pragma unroll
        for (int ai = 0; ai < 2; ++ai)
#pragma unroll
            for (int m = 0; m < 4; ++m) { const unsigned off = boff + ((unsigned)(row0 + ai * 128 + m * 16) * (unsigned)pitch + (unsigned)col0) * 2u;
#pragma unroll
                for (int bj = 0; bj < 2; ++bj) { f32x4 v0 = acc[ai][bj][m][0], v1 = acc[ai][bj][m][1];
                    if (act) { v0 = silu4(v0); v1 = silu4(v1); }
                    v4u w; w.x = pk2(v0[0], v0[1]); w.y = pk2(v0[2], v0[3]); w.z = pk2(v1[0], v1[1]); w.w = pk2(v1[2], v1[3]);
                    *(v4u*)(base + off + bj * 256) = w; } }
    }
};

constexpr float C2 = 0.125f * 1.4426950408889634f;
struct Epi1b {
    static constexpr bool PERM = false, AFTER_DRAIN = false;
    bf16 *q, *kbuf, *vbuf, *yab; float *nk, *nv; const LAS float* tab;
    __device__ __forceinline__ void operator()(const pg8::f32x4 (&acc)[2][2][4][2], const pg8::Unit& u, int wr_, int wc_, int fr_, int fq_) const {
        int fr = fr_, fq = fq_, wr = wr_, wc = wc_; asm volatile("" : "+v"(fr), "+v"(fq), "+v"(wr), "+v"(wc));
        const int pn = u.pn; const int row0 = u.pm * 256 + wr * 64 + fr; const bool prompt = (u.pm < 16);
        if (pn < 8) {
            const bool isq = pn < 4; const int colt = (pn & 3) * 256 + 64 * wc;
            const LAS float* nwp = tab + (isq ? 2048 : 2112);
#pragma unroll
            for (int ai = 0; ai < 2; ++ai)
#pragma unroll
                for (int m = 0; m < 4; ++m) { const int row = row0 + ai * 128 + m * 16;
                    f32x4 x[2][2]; float ss = 0.f;
#pragma unroll
                    for (int bj = 0; bj < 2; ++bj)
#pragma unroll
                        for (int n = 0; n < 2; ++n) { x[bj][n] = acc[ai][bj][m][n]; ss += x[bj][n][0] * x[bj][n][0] + x[bj][n][1] * x[bj][n][1] + x[bj][n][2] * x[bj][n][2] + x[bj][n][3] * x[bj][n][3]; }
                    ss += __shfl_xor(ss, 16); ss += __shfl_xor(ss, 32);
                    const float rstd = rsqrtf(ss * (1.f / 64.f) + 1e-6f);
#pragma unroll
                    for (int bj = 0; bj < 2; ++bj)
#pragma unroll
                        for (int n = 0; n < 2; ++n) x[bj][n] = x[bj][n] * rstd * *(const LAS f32x4*)(nwp + 32 * bj + 16 * n + 4 * fq);
                    if (!isq && prompt) {
                        float* o = nk + (size_t)row * 1024 + colt + 4 * fq;
#pragma unroll
                        for (int bj = 0; bj < 2; ++bj)
#pragma unroll
                            for (int n = 0; n < 2; ++n) *(f32x4*)(o + 32 * bj + 16 * n) = x[bj][n];
                    }
                    if (!prompt) {
                        const int t = (row - NTP) & 4095;
#pragma unroll
                        for (int bj = 0; bj < 2; ++bj) { const int pos = bj ? (t & 63) : (t >> 6);
                            const LAS float* rp = tab + pos * 32 + 4 * fq; const f32x4 cs = *(const LAS f32x4*)rp, sn = *(const LAS f32x4*)(rp + 16);
                            const f32x4 a = x[bj][0], b = x[bj][1];
                            x[bj][0] = a * cs - b * sn; x[bj][1] = b * cs + a * sn; }
                    }
                    bf16* o = isq ? (q + (size_t)row * 1024) : (kbuf + kvrow(row) * 1024);
                    o += colt + ((fq & 1) ? 12 + 4 * fq : 4 * fq); const float sc = isq ? C2 : 1.f;
#pragma unroll
                    for (int bj = 0; bj < 2; ++bj) { const f32x4 y0 = x[bj][0] * sc, y1 = x[bj][1] * sc; v4u w;
                        typedef unsigned u2_t __attribute__((ext_vector_type(2)));
                        const u2_t s0 = __builtin_amdgcn_permlane16_swap(pk2(y0[0], y0[1]), pk2(y1[0], y1[1]), false, false), s1 = __builtin_amdgcn_permlane16_swap(pk2(y0[2], y0[3]), pk2(y1[2], y1[3]), false, false);
                        w.x = s0[0]; w.y = s1[0]; w.z = s0[1]; w.w = s1[1];
                        *(v4u*)(o + 32 * bj) = w; }
                }
        } else {
            const bool isv = pn < 12; const int colt = (pn & 3) * 256, col0 = colt + wc * 32 + 8 * fq;
#pragma unroll
            for (int ai = 0; ai < 2; ++ai)
#pragma unroll
                for (int m = 0; m < 4; ++m) { const int row = row0 + ai * 128 + m * 16;
                    bf16* rowp = isv ? (vbuf + kvrow(row) * 1024 + col0) : (yab + (size_t)row * 2048 + 1024 + col0);
#pragma unroll
                    for (int bj = 0; bj < 2; ++bj) { f32x4 v0 = acc[ai][bj][m][0], v1 = acc[ai][bj][m][1];
                        if (isv && prompt) { float* o = nv + (size_t)row * 1024 + col0 + bj * 128; *(f32x4*)o = v0; *(f32x4*)(o + 4) = v1; }
                        if (!isv) { v0 = silu4(v0); v1 = silu4(v1); }
                        v4u w; w.x = pk2(v0[0], v0[1]); w.y = pk2(v0[2], v0[3]); w.z = pk2(v1[0], v1[1]); w.w = pk2(v1[2], v1[3]);
                        *(v4u*)(rowp + bj * 128) = w; } }
        }
    }
};

typedef _Float16 h2_t __attribute__((ext_vector_type(2)));
__device__ __forceinline__ unsigned ph2x(float a, float b) { h2_t h; h.x = (_Float16)a; h.y = (_Float16)b; return __builtin_bit_cast(unsigned, h); }
__device__ __forceinline__ float hlo(unsigned u) { return (float)__builtin_bit_cast(h2_t, u).x; }
__device__ __forceinline__ float hhi(unsigned u) { return (float)__builtin_bit_cast(h2_t, u).y; }
template <bool FIRST> struct EpiResT {
    static constexpr bool PERM = false, AFTER_DRAIN = false;
    const float *xp, *xs; float* out; bf16* xb; const float* ada;
    float* part; unsigned* cnt;
    template <int AI> __device__ __forceinline__ void store_half(const pg8::f32x4 (&acc)[2][2][4][2], const float* gate, const float* xin, int row0, int col0, int fq) const {
        typedef unsigned u2_t __attribute__((ext_vector_type(2)));
        f32x4 g[2][2];
#pragma unroll
        for (int bj = 0; bj < 2; ++bj)
#pragma unroll
            for (int n = 0; n < 2; ++n) g[bj][n] = *(const f32x4*)(gate + bj * 128 + n * 16);
        const int cb = col0 - 4 * fq + ((fq & 1) ? 12 + 4 * fq : 4 * fq);
#pragma unroll
        for (int m = 0; m < 4; ++m) { const size_t off = (size_t)(row0 + AI * 128 + m * 16) * 1024;
#pragma unroll
            for (int bj = 0; bj < 2; ++bj) {
                if (FIRST) {
                    const f32x4 y0 = *(const f32x4*)(xin + off + col0 + bj * 128) + g[bj][0] * acc[AI][bj][m][0], y1 = *(const f32x4*)(xin + off + col0 + bj * 128 + 16) + g[bj][1] * acc[AI][bj][m][1];
                    const u2_t s0 = __builtin_amdgcn_permlane16_swap(pk2(y0[0], y0[1]), pk2(y1[0], y1[1]), false, false), s1 = __builtin_amdgcn_permlane16_swap(pk2(y0[2], y0[3]), pk2(y1[2], y1[3]), false, false);
                    v4u w; w.x = s0[0]; w.y = s1[0]; w.z = s0[1]; w.w = s1[1];
                    *(v4u*)(xb + off + cb + bj * 128) = w;
                } else {
                    const v4u w = *(const v4u*)(xb + off + cb + bj * 128);
                    const u2_t s0 = __builtin_amdgcn_permlane16_swap(w.x, w.z, false, false), s1 = __builtin_amdgcn_permlane16_swap(w.y, w.w, false, false);
                    const f32x4 x0 = {bflo(s0[0]), bfhi(s0[0]), bflo(s1[0]), bfhi(s1[0])}, x1 = {bflo(s0[1]), bfhi(s0[1]), bflo(s1[1]), bfhi(s1[1])};
                    *(f32x4*)(out + off + col0 + bj * 128) = x0 + g[bj][0] * acc[AI][bj][m][0];
                    *(f32x4*)(out + off + col0 + bj * 128 + 16) = x1 + g[bj][1] * acc[AI][bj][m][1];
                } } }
    }
    template <int AI> __device__ __forceinline__ void finish_split(pg8::f32x4 (&acc)[2][2][4][2], const pg8::Unit& u, __amdgpu_buffer_rsrc_t rs, unsigned lo, int wcu, const float* gate, const float* xin, int row0, int col0, int fq) const {
        const int j = u.part;
#pragma unroll
        for (int jj = 1; jj < 4; ++jj) {
            const int js = (j + jj) & 3;
            const unsigned sb = (unsigned)((((u.tix * 4 + js) * 3 + (3 - jj)) * 4 + wcu) * 8) * 1024u;
            v4u t[8];
#pragma unroll
            for (int r = 0; r < 8; ++r) t[r] = __builtin_amdgcn_raw_buffer_load_b128(rs, lo, sb + (unsigned)(r * 1024), 0);
#pragma unroll
            for (int r = 0; r < 8; ++r) { f32x4 a0 = acc[AI][r >> 2][r & 3][0], a1 = acc[AI][r >> 2][r & 3][1];
                a0.x += hlo(t[r].x); a0.y += hhi(t[r].x); a0.z += hlo(t[r].y); a0.w += hhi(t[r].y); a1.x += hlo(t[r].z); a1.y += hhi(t[r].z); a1.z += hlo(t[r].w); a1.w += hhi(t[r].w);
                asm volatile("" : "+v"(a0), "+v"(a1) :: "memory");
                acc[AI][r >> 2][r & 3][0] = a0; acc[AI][r >> 2][r & 3][1] = a1; } }
        store_half<AI>(acc, gate, xin, row0, col0, fq);
    }
    __device__ __forceinline__ void operator()(pg8::f32x4 (&acc)[2][2][4][2], const pg8::Unit& u, int wr_, int wc_, int fr_, int fq_) const {
        int fr = fr_, fq = fq_, wr = wr_, wc = wc_; asm volatile("" : "+v"(fr), "+v"(fq), "+v"(wr), "+v"(wc));
        const int row0 = u.pm * 256 + wr * 64 + fr, col0 = u.pn * 256 + wc * 32 + 4 * fq;
        const int vec = (u.pm < 16) ? 0 : 1 + ((u.pm - 16) >> 4);
        const float* gate = ada + (size_t)vec * 3072 + 2048 + col0;
        const float* xin = (u.pm < 16) ? xp : xs;
        if (u.part >= 0) {
            const int j = u.part, lane = fq * 16 + fr, wru = __builtin_amdgcn_readfirstlane(wr), wcu = __builtin_amdgcn_readfirstlane(wc);
            const unsigned long long pa_ = (unsigned long long)part;
            float* part_u = (float*)(((unsigned long long)(unsigned)__builtin_amdgcn_readfirstlane((int)(pa_ >> 32)) << 32) | (unsigned)__builtin_amdgcn_readfirstlane((int)pa_));
            const __amdgpu_buffer_rsrc_t rs = __builtin_amdgcn_make_buffer_rsrc(part_u, 0, 24 << 20, 0x00020000); const unsigned lo = (unsigned)lane * 16u;
#pragma unroll
            for (int ai = 0; ai < 2; ++ai) { const int q = 2 * ai + wru;
                if (q != j) {
                    const unsigned base = (unsigned)((((u.tix * 4 + j) * 3 + ((q - j - 1) & 3)) * 4 + wcu) * 8) * 1024u;
#pragma unroll
                    for (int bj = 0; bj < 2; ++bj)
#pragma unroll
                        for (int m = 0; m < 4; ++m) { const f32x4 v0 = acc[ai][bj][m][0], v1 = acc[ai][bj][m][1]; v4u w; w.x = ph2x(v0.x, v0.y); w.y = ph2x(v0.z, v0.w); w.z = ph2x(v1.x, v1.y); w.w = ph2x(v1.z, v1.w);
                            __builtin_amdgcn_raw_buffer_store_b128(w, rs, lo, base + (unsigned)((bj * 4 + m) * 1024), 16  ); } } }
            asm volatile("s_waitcnt vmcnt(0)" ::: "memory");
            unsigned* c = cnt + u.tix * 32;
            if (lane == 0) (void)__hip_atomic_fetch_add(c, 1u, __ATOMIC_RELAXED, __HIP_MEMORY_SCOPE_AGENT);
            if (wru != (j & 1)) return;
            { unsigned sp = 0; while ((unsigned)__builtin_amdgcn_readfirstlane(__hip_atomic_load(c, __ATOMIC_RELAXED, __HIP_MEMORY_SCOPE_AGENT)) < 32u && ++sp < (1u << 22)) __builtin_amdgcn_s_sleep(1); }
            __builtin_amdgcn_fence(__ATOMIC_ACQUIRE, "agent");
            if ((j >> 1) == 0) finish_split<0>(acc, u, rs, lo, wcu, gate, xin, row0, col0, fq); else finish_split<1>(acc, u, rs, lo, wcu, gate, xin, row0, col0, fq);
            return;
        }
        store_half<0>(acc, gate, xin, row0, col0, fq); store_half<1>(acc, gate, xin, row0, col0, fq);
    }
};

struct EpiGate {
    static constexpr bool PERM = false, AFTER_DRAIN = false;
    bf16* pg;
    __device__ __forceinline__ void operator()(const pg8::f32x4 (&acc)[2][2][4][2], const pg8::Unit& u, int wr_, int wc_, int fr_, int fq_) const {
        int fr = fr_, fq = fq_, wr = wr_, wc = wc_; asm volatile("" : "+v"(fr), "+v"(fq), "+v"(wr), "+v"(wc));
        const int row0 = u.pm * 256 + wr * 64 + fr, ch0 = u.pn * 64 + 16 * wc + 4 * fq;
#pragma unroll
        for (int ai = 0; ai < 2; ++ai)
#pragma unroll
            for (int m = 0; m < 4; ++m) { bf16* rowp = pg + (size_t)(row0 + ai * 128 + m * 16) * 4096 + ch0;
                const f32x4 bg = acc[ai][0][m][0], cg = acc[ai][0][m][1], uu = acc[ai][1][m][0], z = acc[ai][1][m][1];
                const f32x4 pp = cg * uu, gt = bg * silu4(z);
                v2u w; w.x = pk2(pp[0], pp[1]); w.y = pk2(pp[2], pp[3]); *(v2u*)rowp = w;
                w.x = pk2(gt[0], gt[1]); w.y = pk2(gt[2], gt[3]); *(v2u*)(rowp + 2048) = w; }
    }
};

struct EpiGateConv {
    static constexpr bool PERM = false, AFTER_DRAIN = false;
    bf16* y2; float* sb; const float* cw; const float* cb; LAS float* xl;
    __device__ __forceinline__ void operator()(pg8::f32x4 (&acc)[2][2][4][2], const pg8::Unit& u, int wr_, int wc_, int fr_, int fq_) const {
        int fr = fr_, fq = fq_, wr = wr_, wc = wc_; asm volatile("" : "+v"(fr), "+v"(fq), "+v"(wr), "+v"(wc));
        const int row0 = u.pm * 256 + wr * 64 + fr, ch0 = u.pn * 64 + 16 * wc + 4 * fq, wid = wr * 4 + wc;
        const f32x4 w0 = *(const f32x4*)(cw + ch0), w1 = *(const f32x4*)(cw + 2048 + ch0), w2 = *(const f32x4*)(cw + 4096 + ch0), bb = *(const f32x4*)(cb + ch0);
#pragma unroll
        for (int ai = 0; ai < 2; ++ai) {
#pragma unroll
            for (int m = 0; m < 4; ++m) acc[ai][0][m][1] = acc[ai][0][m][1] * acc[ai][1][m][0];
            if (fr == 0)  *(LAS f32x4*)(xl + ((wid * 2 + ai) * 2 + 0) * 16 + 4 * fq) = acc[ai][0][0][1];
            if (fr == 15) *(LAS f32x4*)(xl + ((wid * 2 + ai) * 2 + 1) * 16 + 4 * fq) = acc[ai][0][3][1]; }
        asm volatile("s_waitcnt lgkmcnt(0)" ::: "memory"); __builtin_amdgcn_s_barrier();
        const int ow = wid ^ 4;
        const f32x4 z4 = {0.f, 0.f, 0.f, 0.f};
        f32x4 hp[2], hn[2];
        hp[0] = (wr == 0) ? z4 : *(const LAS f32x4*)(xl + ((ow * 2 + 0) * 2 + 1) * 16 + 4 * fq);
        hn[0] = (wr == 0) ? *(const LAS f32x4*)(xl + ((ow * 2 + 0) * 2 + 0) * 16 + 4 * fq) : *(const LAS f32x4*)(xl + ((ow * 2 + 1) * 2 + 0) * 16 + 4 * fq);
        hp[1] = (wr == 0) ? *(const LAS f32x4*)(xl + ((ow * 2 + 0) * 2 + 1) * 16 + 4 * fq) : *(const LAS f32x4*)(xl + ((ow * 2 + 1) * 2 + 1) * 16 + 4 * fq);
        hn[1] = (wr == 0) ? *(const LAS f32x4*)(xl + ((ow * 2 + 1) * 2 + 0) * 16 + 4 * fq) : z4;
        const bool f0 = (fr == 0), f15 = (fr == 15);
        v2u yw[4];
#pragma unroll
        for (int ai = 0; ai < 2; ++ai)
#pragma unroll
            for (int m = 0; m < 4; ++m) {
                const f32x4 c = acc[ai][0][m][1];
                f32x4 up, dn, pe, ne;
#pragma unroll
                for (int e = 0; e < 4; ++e) { up[e] = dppf<0x121>(c[e]); dn[e] = dppf<0x12F>(c[e]); }
                if (m > 0) {
#pragma unroll
                    for (int e = 0; e < 4; ++e) pe[e] = dppf<0x121>(acc[ai][0][m > 0 ? m - 1 : 0][1][e]); } else pe = hp[ai];
                if (m < 3) {
#pragma unroll
                    for (int e = 0; e < 4; ++e) ne[e] = dppf<0x12F>(acc[ai][0][m < 3 ? m + 1 : 3][1][e]); } else ne = hn[ai];
                const f32x4 pv = f0 ? pe : up, nx = f15 ? ne : dn;
                const f32x4 gt = acc[ai][0][m][0] * silu4(acc[ai][1][m][1]);
                const f32x4 y = gt * (w0 * pv + w1 * c + w2 * nx + bb);
                yw[m].x = pk2(y[0], y[1]); yw[m].y = pk2(y[2], y[3]);
                if (m & 1) {
                    typedef unsigned u2_t __attribute__((ext_vector_type(2)));
                    const u2_t s0 = __builtin_amdgcn_permlane16_swap(yw[m - (m & 1)].x, yw[m].x, false, false), s1 = __builtin_amdgcn_permlane16_swap(yw[m - (m & 1)].y, yw[m].y, false, false);
                    v4u w; w.x = s0[0]; w.y = s1[0]; w.z = s0[1]; w.w = s1[1];
                    *(v4u*)(y2 + (size_t)(row0 + ai * 128 + (m - 1 + (fq & 1)) * 16) * 2048 + ch0 - 4 * (fq & 1)) = w; }
                if (ai == 0 && m == 0) { if (wr == 0 && fr < 2) { float* d = sb + ((size_t)u.pm * 6 + fr) * 2048 + ch0; *(f32x4*)d = c; if (fr == 0) *(f32x4*)(d + 4 * 2048) = gt; } }
                if (ai == 1 && m == 3) { if (wr == 1 && fr >= 14) { float* d = sb + ((size_t)u.pm * 6 + 2 + (fr - 14)) * 2048 + ch0; *(f32x4*)d = c; if (fr == 15) *(f32x4*)(sb + ((size_t)u.pm * 6 + 5) * 2048 + ch0) = gt; } }
            }
    }
};
__device__ __forceinline__ void conv_fix_phase(const Params& p, int vcu, int G) {
    const float* sb = (const float*)(p.ws + WS_CSB); bf16* y2 = (bf16*)(p.ws + WS_YAB); const float* cw = p.in[I_CONVW]; const float* cb = p.in[I_CONVB];
    for (int it = vcu * NTHR + threadIdx.x; it < 60 * 2 * 512; it += G * NTHR) {
        const int c4 = (it & 511) * 4, side = (it >> 9) & 1, bd = it >> 10, seq = bd / 15, ta = 16 + seq * 16 + (bd % 15), tb = ta + 1;
        const float* A = sb + (size_t)ta * 6 * 2048 + c4; const float* B = sb + (size_t)tb * 6 * 2048 + c4;
        const f32x4 w0 = *(const f32x4*)(cw + c4), w1 = *(const f32x4*)(cw + 2048 + c4), w2 = *(const f32x4*)(cw + 4096 + c4), bb = *(const f32x4*)(cb + c4);
        f32x4 pv, c, nx, gt; int row;
        if (side == 0) { pv = *(const f32x4*)(A + 2 * 2048); c = *(const f32x4*)(A + 3 * 2048); nx = *(const f32x4*)(B); gt = *(const f32x4*)(A + 5 * 2048); row = ta * 256 + 255; }
        else           { pv = *(const f32x4*)(A + 3 * 2048); c = *(const f32x4*)(B); nx = *(const f32x4*)(B + 2048); gt = *(const f32x4*)(B + 4 * 2048); row = tb * 256; }
        const f32x4 y = gt * (w0 * pv + w1 * c + w2 * nx + bb);
        v2u w; w.x = pk2(y[0], y[1]); w.y = pk2(y[2], y[3]);
        *(v2u*)(y2 + (size_t)row * 2048 + c4) = w;
    }
}
constexpr int S3_LW = 16384, S3_LA = 24576;
constexpr int S3_XF = 0, S3_YF = 16384;
constexpr int S3_RAW = 34816;
constexpr int S3_LWD = 34816, S3_KK = 51200, S3_BB = 59392, S3_KD = 67584, S3_RR = 75776;
constexpr int S3_BKF = 83968, S3_VTF = 100352, S3_AKB = 108544, S3_TTF = 112640, S3_AOF = 116736, S3_ABB = 124928, S3_SF = 129024, S3_OBUF = 131072, S3_CST = 139264, S3_END = 141824;
constexpr int S3_CF = S3_END;
static_assert(S3_CF + 1280 <= LDS_MISC, "scan LDS map");
struct ScanPtrs { const bf16 *par, *pak, *pav, *pal; bf16 *ofp, *ofs, *ob; float* bn; const bf16* wupt; bf16* yab; float* smid; };
__device__ __forceinline__ unsigned pkh2(float lo, float hi) { typedef _Float16 h2_t __attribute__((ext_vector_type(2))); h2_t v = {(_Float16)lo, (_Float16)hi}; return __builtin_bit_cast(unsigned, v); }
__device__ __forceinline__ h8 cvt8(const f32x16& x, int o) { v4u w; w.x = pkh2(x[o], x[o + 1]); w.y = pkh2(x[o + 2], x[o + 3]); w.z = pkh2(x[o + 4], x[o + 5]); w.w = pkh2(x[o + 6], x[o + 7]); return __builtin_bit_cast(h8, w); }
#define SQ_HI(q) (((q) >> 2) & 1)
#define SQ_E(q) ((((q) >> 3) << 2) | ((q) & 3))

__device__ __forceinline__ void scan_chain(const Params& p, const ScanPtrs& sp, LAS unsigned char* lds, int chain, int half) {
    const int tid = threadIdx.x, lane = tid & 63; const int wid = __builtin_amdgcn_readfirstlane(tid >> 6);
    const bool smp = chain < 128; const int cc = smp ? chain : chain - 128;
    const int d = cc & 1, h = (cc >> 1) & 15, b = cc >> 5;
    const int T = smp ? TS : TP, tok0 = smp ? NTP + b * TS : b * TP;
    const int tb0 = (half == 1) ? 32 : 0, tb1 = (half == 0) ? 32 : T / 64, nseq = (half == 1) ? 4 : 2;
    __syncthreads();
    for (int i = tid; i < 640; i += NTHR) { const int a = i >> 6, j = i & 63, cj = h * 64 + j; float v;
        if (a == 0) v = p.in[I_MU][cj]; else if (a == 1) v = p.in[I_MU][1024 + cj]; else if (a == 2) v = p.in[I_MU][2048 + cj];
        else if (a == 3) v = p.in[I_MU][3072 + 64 * d + j]; else if (a == 4) v = p.in[I_MU][3200 + 64 * d + j];
        else if (a == 5) v = p.in[I_W0][d * 1024 + cj]; else if (a == 6) v = p.in[I_A0][d * 1024 + cj];
        else if (a == 7) v = p.in[I_KK][cj]; else if (a == 8) v = p.in[I_KA][cj]; else v = p.in[I_RK][cj];
        ((LAS float*)(lds + S3_CST))[i] = v; }
    const int r32o = lane & 31, hio = lane >> 5;
    f32x16 St[2];
    St[0] = (f32x16){}; St[1] = (f32x16){};
    if (wid < 2 && smp && half != 1) { const float* s0 = p.in[d ? I_SB : I_SF] + ((size_t)(b * 16 + h) * 64 + 32 * wid + r32o) * 64;
#pragma unroll
        for (int kt = 0; kt < 2; ++kt)
#pragma unroll
            for (int rg = 0; rg < 4; ++rg) { const f32x4 a = *(const f32x4*)(s0 + 32 * kt + 8 * rg + 4 * hio); St[kt][4 * rg] = a.x; St[kt][4 * rg + 1] = a.y; St[kt][4 * rg + 2] = a.z; St[kt][4 * rg + 3] = a.w; } }
    { const bool isv = (half == 1) && (wid >= 2);
      const float m0 = (isv && wid == 2) ? 1.f : 0.f, m1 = (isv && wid == 3) ? 1.f : 0.f;
      f32x16 e;
#pragma unroll
      for (int r = 0; r < 16; ++r) e[r] = (8 * (r >> 2) + 4 * hio + (r & 3) == r32o) ? 1.f : 0.f;
      St[0] = St[0] + e * m0; St[1] = St[1] + e * m1; }
    const unsigned lds0 = (unsigned)(uintptr_t)lds;
#define SC_DMA(tb_) do { const int tlo_ = d ? (T - 64 * ((tb_) + 1)) : (64 * (tb_)); int l_ = lane; asm volatile("" : "+v"(l_)); \
        for (int n_ = wid; n_ < 42; n_ += 8) { int sg_ = 8 * n_ + (l_ >> 3); sg_ = sg_ < 330 ? sg_ : 329; const int rho_ = sg_ / 5, arr_ = sg_ - 5 * rho_; \
            int t_ = tlo_ - 1 + rho_; t_ = t_ < 0 ? 0 : (t_ >= T ? T - 1 : t_); const size_t m_ = (size_t)(tok0 + t_); \
            const bf16* src_ = (arr_ == 0) ? sp.par + m_ * 1024 + h * 64 : (arr_ == 1) ? sp.pak + m_ * 1024 + h * 64 : (arr_ == 2) ? sp.pav + m_ * 1024 + h * 64 : (arr_ == 3) ? sp.pal + m_ * 256 + 64 * d : sp.pal + m_ * 256 + 128 + 64 * d; \
            glds16(src_ + (l_ & 7) * 8, (unsigned)__builtin_amdgcn_readfirstlane(lds0 + S3_RAW + n_ * 1024)); } } while (0)
#define SC_SIDE(tb_) do { int l_ = lane; asm volatile("" : "+v"(l_)); const int wq_ = wid - 4, pe_ = l_ >> 3, jg_ = l_ & 7; \
        const LAS float* cst_ = (const LAS float*)(lds + S3_CST) + 8 * jg_; const int tlo_ = d ? (T - 64 * ((tb_) + 1)) : (64 * (tb_)); \
        bf16x8 bf_[2][4][2];     \
        _Pragma("unroll") for (int mat_ = 0; mat_ < 2; ++mat_) { const bf16* wb_ = sp.wupt + ((size_t)(mat_ * 2 + d) * 1024 + h * 64) * 64 + (l_ & 15) * 64 + 8 * (l_ >> 4); \
            _Pragma("unroll") for (int nt_ = 0; nt_ < 4; ++nt_) { bf_[mat_][nt_][0] = *(const bf16x8*)(wb_ + 16 * nt_ * 64); bf_[mat_][nt_][1] = *(const bf16x8*)(wb_ + 16 * nt_ * 64 + 32); } } \
        _Pragma("unroll") for (int q_ = 0; q_ < 2; ++q_) { const int vw_ = 2 * wq_ + q_; \
            const int tmin_ = d ? (T - 1 - ((tb_) * 64 + 8 * vw_ + 7)) : ((tb_) * 64 + 8 * vw_); const int i_ = 8 * vw_ + (d ? (7 - pe_) : pe_), t_ = tmin_ + pe_; \
            const bool okp_ = t_ > 0, okn_ = t_ < T - 1; const LAS unsigned char* rw_ = lds + S3_RAW + (t_ - tlo_) * 640 + jg_ * 16; \
            _Pragma("unroll") for (int arr_ = 3; arr_ < 5; ++arr_) { v4u r0_ = *(const LAS v4u*)(rw_ + arr_ * 128), r1_ = *(const LAS v4u*)(rw_ + 640 + arr_ * 128), r2_ = *(const LAS v4u*)(rw_ + 1280 + arr_ * 128); \
                if (!okp_) r0_ = (v4u){0u, 0u, 0u, 0u}; if (!okn_) r2_ = (v4u){0u, 0u, 0u, 0u}; v4u o_; \
                _Pragma("unroll") for (int c2_ = 0; c2_ < 4; ++c2_) { \
                    const float xl_ = bflo(r1_[c2_]), xh_ = bfhi(r1_[c2_]); \
                    float yl_ = xl_ + cst_[64 * arr_ + 2 * c2_] * (0.5f * (bflo(r0_[c2_]) + bflo(r2_[c2_])) - xl_), yh_ = xh_ + cst_[64 * arr_ + 2 * c2_ + 1] * (0.5f * (bfhi(r0_[c2_]) + bfhi(r2_[c2_])) - xh_); \
                    if (arr_ == 3) { yl_ = 1.f - 2.f * frcp(1.f + __expf(2.f * yl_)); yh_ = 1.f - 2.f * frcp(1.f + __expf(2.f * yh_)); } \
                    o_[c2_] = pk2(yl_, yh_); } \
                *(LAS v4u*)(lds + (arr_ == 3 ? S3_LW : S3_LA) + (i_ * 64 + 8 * jg_) * 2) = o_; } } \
        asm volatile("s_waitcnt lgkmcnt(0)" ::: "memory"); \
        _Pragma("unroll") for (int mat_ = 0; mat_ < 2; ++mat_) { \
            const LAS unsigned char* ab_ = lds + (mat_ ? S3_LA : S3_LW) + ((16 * wq_ + (l_ & 15)) * 64 + 8 * (l_ >> 4)) * 2; \
            const bf16x8 a0_ = *(const LAS bf16x8*)ab_, a1_ = *(const LAS bf16x8*)(ab_ + 64); \
            f32x4 c_[4]; _Pragma("unroll") for (int nt_ = 0; nt_ < 4; ++nt_) { c_[nt_] = (f32x4){0.f, 0.f, 0.f, 0.f}; \
                c_[nt_] = __builtin_amdgcn_mfma_f32_16x16x32_bf16(a0_, bf_[mat_][nt_][0], c_[nt_], 0, 0, 0); c_[nt_] = __builtin_amdgcn_mfma_f32_16x16x32_bf16(a1_, bf_[mat_][nt_][1], c_[nt_], 0, 0, 0); } \
            asm volatile("s_waitcnt lgkmcnt(0)" ::: "memory");     \
            LAS unsigned short* out_ = (LAS unsigned short*)(lds + (mat_ ? S3_LA : S3_LW)) + (16 * wq_ + 4 * (l_ >> 4)) * 64 + (l_ & 15); \
              \
            _Pragma("unroll") for (int nt_ = 0; nt_ < 4; ++nt_) { const float bias_ = ((const LAS float*)(lds + S3_CST))[(mat_ ? 384 : 320) + 16 * nt_ + (l_ & 15)]; const float sc_ = mat_ ? 1.f : -0.6065306597126334f; \
                _Pragma("unroll") for (int r_ = 0; r_ < 4; ++r_) { const _Float16 hv_ = (_Float16)(sc_ * sigmf(bias_ + c_[nt_][r_])); out_[64 * r_ + 16 * nt_] = __builtin_bit_cast(unsigned short, hv_); } } } } while (0)
    SC_DMA(tb0);
    asm volatile("s_waitcnt vmcnt(0)" ::: "memory"); __syncthreads();
    if (wid >= 4) SC_SIDE(tb0);
    __syncthreads();
    for (int tb = tb0; tb < tb1; ++tb) {
        int ln = lane; asm volatile("" : "+v"(ln));
        const int r32 = ln & 31, hi = ln >> 5, pe = ln >> 3, jg = ln & 7;
        const int tmin = d ? (T - 1 - (tb * 64 + 8 * wid + 7)) : (tb * 64 + 8 * wid);
        const int i = 8 * wid + (d ? (7 - pe) : pe), t = tmin + pe;
        float rm[8], km[8], vm[8];
        { const LAS float* cst = (const LAS float*)(lds + S3_CST) + 8 * jg;
          const int tlo = d ? (T - 64 * (tb + 1)) : (64 * tb);
          const bool okp = t > 0, okn = t < T - 1;
          const LAS unsigned char* rw = lds + S3_RAW + (t - tlo) * 640 + jg * 16;
#pragma unroll
          for (int arr = 0; arr < 3; ++arr) { v4u r0 = *(const LAS v4u*)(rw + arr * 128), r1 = *(const LAS v4u*)(rw + 640 + arr * 128), r2 = *(const LAS v4u*)(rw + 1280 + arr * 128);
              if (!okp) r0 = (v4u){0u, 0u, 0u, 0u}; if (!okn) r2 = (v4u){0u, 0u, 0u, 0u};
#pragma unroll
              for (int c2 = 0; c2 < 4; ++c2) {
#pragma unroll
                  for (int hh = 0; hh < 2; ++hh) { const int jj = 2 * c2 + hh;
                      const float x = hh ? bfhi(r1[c2]) : bflo(r1[c2]), nb = hh ? (bfhi(r0[c2]) + bfhi(r2[c2])) : (bflo(r0[c2]) + bflo(r2[c2]));
                      const float y = x + cst[64 * arr + jj] * (0.5f * nb - x);
                      if (arr == 0) rm[jj] = y; else if (arr == 1) km[jj] = y; else vm[jj] = y; } } } }
        __syncthreads();
        { const LAS float* cst = (const LAS float*)(lds + S3_CST) + 8 * jg;
          const v4u lwv = *(const LAS v4u*)(lds + S3_LW + (i * 64 + 8 * jg) * 2), lav = *(const LAS v4u*)(lds + S3_LA + (i * 64 + 8 * jg) * 2);
          float lwd[8], av[8], kkr[8], kd[8]; float ssq = 0.f, bon = 0.f;
          const h8 lwh = __builtin_bit_cast(h8, lwv), lah = __builtin_bit_cast(h8, lav);
#pragma unroll
          for (int jj = 0; jj < 8; ++jj) {
              lwd[jj] = (float)lwh[jj];
              av[jj] = (float)lah[jj];
              kkr[jj] = km[jj] * cst[448 + jj]; ssq += kkr[jj] * kkr[jj];
              kd[jj] = km[jj] * (1.f + (av[jj] - 1.f) * cst[512 + jj]);
              bon += rm[jj] * kd[jj] * cst[576 + jj]; }
          ssq = sum8(ssq); bon = sum8(bon);
          const float rinv = frcp(fmaxf(__builtin_amdgcn_sqrtf(ssq), 1e-12f));
          if (jg == 0) sp.bn[(size_t)(tok0 + t) * 32 + h * 2 + d] = bon;
          *(LAS f32x4*)(lds + S3_LWD + (i * 64 + 8 * jg) * 4) = (f32x4){lwd[0], lwd[1], lwd[2], lwd[3]};
          *(LAS f32x4*)(lds + S3_LWD + (i * 64 + 8 * jg) * 4 + 16) = (f32x4){lwd[4], lwd[5], lwd[6], lwd[7]};
          v4u o;
#define SC_PACK(expr) do { _Pragma("unroll") for (int c2 = 0; c2 < 4; ++c2) { float x0, x1; { const int jj = 2 * c2; x0 = (expr); } { const int jj = 2 * c2 + 1; x1 = (expr); } o[c2] = pkh2(x0, x1); } } while (0)
          SC_PACK(kkr[jj] * rinv);                *(LAS v4u*)(lds + S3_KK + (i * 64 + 8 * jg) * 2) = o;
          SC_PACK(-(kkr[jj] * rinv) * av[jj]);    *(LAS v4u*)(lds + S3_BB + (i * 64 + 8 * jg) * 2) = o;
          SC_PACK(kd[jj]);                        *(LAS v4u*)(lds + S3_KD + (i * 64 + 8 * jg) * 2) = o;
          SC_PACK(rm[jj]);                        *(LAS v4u*)(lds + S3_RR + (i * 64 + 8 * jg) * 2) = o;
#undef SC_PACK
          { const int c = i >> 4, q = i & 15; LAS _Float16* vt = (LAS _Float16*)(lds + S3_VTF + c * 2048 + ((jg >> 2) * 32 + (jg & 3) * 8) * 32 + SQ_HI(q) * 16 + SQ_E(q) * 2);
#pragma unroll
            for (int jj = 0; jj < 8; ++jj) vt[jj * 16] = (_Float16)vm[jj]; }
        }
        __syncthreads();
        { const int c = wid >> 1, k = ln, ksx = k >> 4, q = k & 15, fo = SQ_HI(q) * 16 + SQ_E(q) * 2;
          float Lc[16];
          { float run = 0.f;
#pragma unroll
            for (int tau = 0; tau < 16; ++tau) { run += ((const LAS float*)(lds + S3_LWD))[(16 * c + tau) * 64 + k]; Lc[tau] = run; } }
          const float Lref = Lc[7];
          if ((wid & 1) == 0) {
              ((LAS float*)(lds + S3_SF))[(c * 2) * 64 + k] = __expf(Lref); ((LAS float*)(lds + S3_SF))[(c * 2 + 1) * 64 + k] = __expf(Lc[15] - Lref);
              LAS unsigned char* xf = lds + S3_XF + c * 4096 + ksx * 1024 + fo;
#pragma unroll
              for (int tau = 0; tau < 16; ++tau) { const float e1 = __expf((tau ? Lc[tau - 1] : 0.f) - Lref), e2 = __expf(Lc[tau] - Lref);
                  const float kkv = (float)((const LAS _Float16*)(lds + S3_KK))[(16 * c + tau) * 64 + k], rv = (float)((const LAS _Float16*)(lds + S3_RR))[(16 * c + tau) * 64 + k];
                  *(LAS _Float16*)(xf + ((tau + 2 * ksx) & 31) * 32) = (_Float16)(kkv * e1); *(LAS _Float16*)(xf + ((16 + tau + 2 * ksx) & 31) * 32) = (_Float16)(rv * e2); }
          } else {
              LAS unsigned char* yf = lds + S3_YF + c * 4096 + ksx * 1024 + fo;
              LAS unsigned char* bk = lds + S3_BKF + c * 4096 + (k >> 5) * 2048 + (k & 31) * 32;
              float bt[16], kt2[16];
#pragma unroll
              for (int tau = 0; tau < 16; ++tau) { const float e3 = __expf(Lref - Lc[tau]);
                  bt[tau] = (float)((const LAS _Float16*)(lds + S3_BB))[(16 * c + tau) * 64 + k] * e3; kt2[tau] = (float)((const LAS _Float16*)(lds + S3_KD))[(16 * c + tau) * 64 + k] * e3;
                  *(LAS _Float16*)(yf + ((tau + 2 * ksx) & 31) * 32) = (_Float16)bt[tau]; *(LAS _Float16*)(yf + ((16 + tau + 2 * ksx) & 31) * 32) = (_Float16)kt2[tau]; }
              *(LAS v4u*)(bk)             = (v4u){pkh2(bt[0], bt[1]), pkh2(bt[2], bt[3]), pkh2(bt[8], bt[9]), pkh2(bt[10], bt[11])};
              *(LAS v4u*)(bk + 16)        = (v4u){pkh2(bt[4], bt[5]), pkh2(bt[6], bt[7]), pkh2(bt[12], bt[13]), pkh2(bt[14], bt[15])};
              *(LAS v4u*)(bk + 1024)      = (v4u){pkh2(kt2[0], kt2[1]), pkh2(kt2[2], kt2[3]), pkh2(kt2[8], kt2[9]), pkh2(kt2[10], kt2[11])};
              *(LAS v4u*)(bk + 1024 + 16) = (v4u){pkh2(kt2[4], kt2[5]), pkh2(kt2[6], kt2[7]), pkh2(kt2[12], kt2[13]), pkh2(kt2[14], kt2[15])};
          } }
        __syncthreads();
        if (tb + 1 < tb1) SC_DMA(tb + 1);
        if (wid >= 4) { const int ci = tid - 256;
            for (int e = ci; e < 320; e += 256) { const int c = e >> 6, k = e & 63; const LAS float* sf = (const LAS float*)(lds + S3_SF);
                ((LAS float*)(lds + S3_CF))[e] = (c == 0) ? sf[k] : (c == 4) ? sf[7 * 64 + k] : sf[(2 * c) * 64 + k] * sf[(2 * c - 1) * 64 + k]; } }
        if (wid < 4) { const int c = wid, fl = r32 * 32 + hi * 16;
            f32x16 G = (f32x16){};
#pragma unroll
            for (int ks = 0; ks < 4; ++ks) { const int flr = ((r32 + 2 * ks) & 31) * 32 + hi * 16;
                G = __builtin_amdgcn_mfma_f32_32x32x16_f16(*(const LAS h8*)(lds + S3_YF + c * 4096 + ks * 1024 + flr), *(const LAS h8*)(lds + S3_XF + c * 4096 + ks * 1024 + flr), G, 0, 0, 0); }
            const int n = r32, tau = n & 15; const bool isr = n >= 16;
#pragma unroll
            for (int r = 0; r < 16; ++r) { const int j = (r & 3) + 8 * ((r >> 2) & 1) + 4 * hi; const bool keep = isr ? (j <= tau) : (j < tau); G[r] = keep ? G[r] : 0.f; }
            const h8 z8 = (h8){};
            if (!isr) {
#pragma unroll
                for (int r = 0; r < 8; ++r) { const int j = (r & 3) + 8 * (r >> 2) + 4 * hi; ((LAS float*)(lds + S3_ABB))[c * 256 + j * 16 + tau] = G[r]; }
                *(LAS h8*)(lds + S3_AKB + c * 1024 + fl) = cvt8(G, 8);
                *(LAS h8*)(lds + S3_AOF + c * 2048 + fl) = z8; *(LAS h8*)(lds + S3_AOF + c * 2048 + 1024 + fl) = z8;
            } else {
                *(LAS h8*)(lds + S3_AKB + c * 1024 + fl) = z8;
                *(LAS h8*)(lds + S3_AOF + c * 2048 + fl) = cvt8(G, 0); *(LAS h8*)(lds + S3_AOF + c * 2048 + 1024 + fl) = cvt8(G, 8);
            }
            asm volatile("s_waitcnt lgkmcnt(0)" ::: "memory");
            { const int ii = ln & 15; float Tc[16]; const LAS float* ab = (const LAS float*)(lds + S3_ABB) + c * 256;
#pragma unroll
              for (int ta = 15; ta >= 0; --ta) { float acc0 = (ta == ii) ? 1.f : 0.f, acc1 = 0.f, acc2 = 0.f, acc3 = 0.f;
                  if ((ta & 3) == 3) asm volatile("" ::: "memory");
#pragma unroll
                  for (int m = ta + 1; m < 16; ++m) { const float pr = ab[ta * 16 + m] * Tc[m]; if ((m & 3) == 0) acc0 += pr; else if ((m & 3) == 1) acc1 += pr; else if ((m & 3) == 2) acc2 += pr; else acc3 += pr; }
                  Tc[ta] = (acc0 + acc1) + (acc2 + acc3); }
              v4u w0, w1;
              w0.x = pkh2(Tc[0], Tc[1]); w0.y = pkh2(Tc[2], Tc[3]); w0.z = pkh2(Tc[8], Tc[9]); w0.w = pkh2(Tc[10], Tc[11]);
              w1.x = pkh2(Tc[4], Tc[5]); w1.y = pkh2(Tc[6], Tc[7]); w1.z = pkh2(Tc[12], Tc[13]); w1.w = pkh2(Tc[14], Tc[15]);
              if (ln < 16) { *(LAS v4u*)(lds + S3_TTF + c * 1024 + ln * 32) = w0; *(LAS v4u*)(lds + S3_TTF + c * 1024 + ln * 32 + 16) = w1; }
              else if (ln < 32) { *(LAS v4u*)(lds + S3_TTF + c * 1024 + ln * 32) = (v4u){0u, 0u, 0u, 0u}; *(LAS v4u*)(lds + S3_TTF + c * 1024 + ln * 32 + 16) = (v4u){0u, 0u, 0u, 0u}; } }
        }
        asm volatile("s_waitcnt vmcnt(0)" ::: "memory");
        __syncthreads();
        if (wid >= 4 && tb + 1 < tb1) SC_SIDE(tb + 1);
        if (wid < nseq) { const int fl = r32 * 32 + hi * 16; const bool virt = wid >= 2; const int vtile = wid & 1;
#pragma unroll 1
            for (int c = 0; c < 4; ++c) {
                f32x4 cf[8];
#pragma unroll
                for (int kt = 0; kt < 2; ++kt)
#pragma unroll
                    for (int rg = 0; rg < 4; ++rg) cf[kt * 4 + rg] = *(const LAS f32x4*)(lds + S3_CF + c * 256 + (32 * kt + 8 * rg + 4 * hi) * 4);
                const LAS unsigned char* xf = lds + S3_XF + c * 4096 + hi * 16;
                const h8 x0 = *(const LAS h8*)(xf + r32 * 32), x1 = *(const LAS h8*)(xf + 1024 + ((r32 + 2) & 31) * 32), x2 = *(const LAS h8*)(xf + 2048 + ((r32 + 4) & 31) * 32), x3 = *(const LAS h8*)(xf + 3072 + ((r32 + 6) & 31) * 32);
                h8 vfr = *(const LAS h8*)(lds + S3_VTF + c * 2048 + vtile * 1024 + fl); if (virt) vfr = (h8){};
                const h8 akb = *(const LAS h8*)(lds + S3_AKB + c * 1024 + fl), ttf = *(const LAS h8*)(lds + S3_TTF + c * 1024 + fl);
                const h8 ao0 = *(const LAS h8*)(lds + S3_AOF + c * 2048 + fl), ao1 = *(const LAS h8*)(lds + S3_AOF + c * 2048 + 1024 + fl);
                const h8 bk00 = *(const LAS h8*)(lds + S3_BKF + c * 4096 + fl), bk01 = *(const LAS h8*)(lds + S3_BKF + c * 4096 + 1024 + fl),
                         bk10 = *(const LAS h8*)(lds + S3_BKF + c * 4096 + 2048 + fl), bk11 = *(const LAS h8*)(lds + S3_BKF + c * 4096 + 3072 + fl);
#pragma unroll
                for (int kt = 0; kt < 2; ++kt)
#pragma unroll
                    for (int rg = 0; rg < 4; ++rg) { const f32x4 f = cf[kt * 4 + rg]; St[kt][4 * rg] *= f.x; St[kt][4 * rg + 1] *= f.y; St[kt][4 * rg + 2] *= f.z; St[kt][4 * rg + 3] *= f.w; }
                const h8 s0 = cvt8(St[0], 0), s1 = cvt8(St[0], 8), s2 = cvt8(St[1], 0), s3 = cvt8(St[1], 8);
                f32x16 P = __builtin_amdgcn_mfma_f32_32x32x16_f16(akb, vfr, (f32x16){}, 0, 0, 0);
                P = __builtin_amdgcn_mfma_f32_32x32x16_f16(x0, s0, P, 0, 0, 0);
                P = __builtin_amdgcn_mfma_f32_32x32x16_f16(x1, s1, P, 0, 0, 0);
                P = __builtin_amdgcn_mfma_f32_32x32x16_f16(x2, s2, P, 0, 0, 0);
                P = __builtin_amdgcn_mfma_f32_32x32x16_f16(x3, s3, P, 0, 0, 0);
                const h8 zf = cvt8(P, 0);
                f32x16 Ut = __builtin_amdgcn_mfma_f32_32x32x16_f16(ttf, zf, (f32x16){}, 0, 0, 0);
                const h8 uf = cvt8(Ut, 0);
                St[0] = __builtin_amdgcn_mfma_f32_32x32x16_f16(bk00, uf, St[0], 0, 0, 0);
                St[1] = __builtin_amdgcn_mfma_f32_32x32x16_f16(bk10, uf, St[1], 0, 0, 0);
                St[0] = __builtin_amdgcn_mfma_f32_32x32x16_f16(bk01, vfr, St[0], 0, 0, 0);
                St[1] = __builtin_amdgcn_mfma_f32_32x32x16_f16(bk11, vfr, St[1], 0, 0, 0);
                P = __builtin_amdgcn_mfma_f32_32x32x16_f16(ao0, uf, P, 0, 0, 0);
                P = __builtin_amdgcn_mfma_f32_32x32x16_f16(ao1, vfr, P, 0, 0, 0);
                if (!virt) {
#pragma unroll
                    for (int r = 8; r < 16; ++r) { const int tau = (r & 3) + 8 * ((r >> 2) & 1) + 4 * hi;
                        *(LAS unsigned short*)(lds + S3_OBUF + ((16 * c + tau) * 64 + 32 * vtile + r32) * 2) = (unsigned short)f2bf(P[r]); }
                } else {
                    _Float16* mt = (_Float16*)(sp.yab + ((size_t)(NTP + b * TS + (tb * 64 + 16 * c - 2048) + 2048 * d) * 2048 + 1024)) + h * 64 + 32 * vtile + r32;
#pragma unroll
                    for (int r = 8; r < 16; ++r) { const int tau = (r & 3) + 8 * ((r >> 2) & 1) + 4 * hi; mt[(size_t)tau * 2048] = (_Float16)P[r]; }
                }
            }
#pragma unroll
            for (int kt = 0; kt < 2; ++kt)
#pragma unroll
                for (int rg = 0; rg < 4; ++rg) { const f32x4 f = *(const LAS f32x4*)(lds + S3_CF + 4 * 256 + (32 * kt + 8 * rg + 4 * hi) * 4);
                    St[kt][4 * rg] *= f.x; St[kt][4 * rg + 1] *= f.y; St[kt][4 * rg + 2] *= f.z; St[kt][4 * rg + 3] *= f.w; }
        }
        __syncthreads();
        { const int fi = tid >> 3, ch = tid & 7; const int ft = d ? (T - 1 - (tb * 64 + fi)) : (tb * 64 + fi);
          const v4u v = *(const LAS v4u*)(lds + S3_OBUF + (fi * 64 + ch * 8) * 2);
          bf16* dst = d ? (sp.ob + (size_t)(tok0 + ft) * 1024) : (smp ? sp.ofs + (size_t)(b * TS + ft) * 1024 : sp.ofp + (size_t)(tok0 + ft) * 1024);
          *(v4u*)(dst + h * 64 + ch * 8) = v; }
    }
#undef SC_DMA
#undef SC_SIDE
    if (wid < 2 && half != 1) { float* o = smp ? sp.smid + ((size_t)chain * 64 + 32 * wid + r32o) * 64 : (float*)((unsigned char*)p.out + (d ? O_SB : O_SF)) + ((size_t)(b * 16 + h) * 64 + 32 * wid + r32o) * 64;
#pragma unroll
        for (int kt = 0; kt < 2; ++kt)
#pragma unroll
            for (int rg = 0; rg < 4; ++rg) *(f32x4*)(o + 32 * kt + 8 * rg + 4 * hio) = (f32x4){St[kt][4 * rg], St[kt][4 * rg + 1], St[kt][4 * rg + 2], St[kt][4 * rg + 3]}; }
}
__device__ __forceinline__ void scan_phase(const Params& p, LAS unsigned char* lds, int vcu, int G) {
    ScanPtrs sp; sp.par = (const bf16*)(p.ws + X_PAR); sp.pak = (const bf16*)(p.ws + X_PAK); sp.pav = (const bf16*)((unsigned char*)p.out + O_PAV); sp.pal = (const bf16*)(p.ws + X_PAL);
    sp.ofp = (bf16*)(p.ws + X_OFP); sp.ofs = (bf16*)((unsigned char*)p.out + O_OFS); sp.ob = (bf16*)((unsigned char*)p.out + O_OB); sp.bn = (float*)(p.ws + WS_BN); sp.wupt = (const bf16*)(p.ws + WS_WUPT);
    sp.yab = (bf16*)(p.ws + WS_YAB); sp.smid = (float*)(p.ws + X_SMID);
    for (int j = vcu; j < 768; j += G) { const int chain = (j < 256) ? (j >> 1) : 128 + (j - 256), half = (j < 256) ? (j & 1) : -1; scan_chain(p, sp, lds, chain, half); }
}
__device__ __forceinline__ void scan_fixup_phase(const Params& p, int vcu, int G) {
    const int lane = threadIdx.x & 63, r32 = lane & 31, hi = lane >> 5; const int wid = __builtin_amdgcn_readfirstlane(threadIdx.x >> 6);
    const bf16* yab = (const bf16*)(p.ws + WS_YAB); const float* smid = (const float*)(p.ws + X_SMID);
    bf16* ofs = (bf16*)((unsigned char*)p.out + O_OFS); bf16* ob = (bf16*)((unsigned char*)p.out + O_OB);
    for (int it = vcu; it < 1024; it += G) { const int chain = it >> 3, slab = it & 7, d = chain & 1, h = (chain >> 1) & 15, b = chain >> 5;
        const int pp = slab * 256 + wid * 32 + r32;
        const _Float16* mrow = (const _Float16*)(yab + ((size_t)(NTP + b * TS + pp + 2048 * d) * 2048 + 1024)) + h * 64 + 8 * hi;
        h8 mf[4];
#pragma unroll
        for (int ks = 0; ks < 4; ++ks) mf[ks] = *(const h8*)(mrow + 16 * ks);
        const int t = d ? (2047 - pp) : (2048 + pp);
        bf16* orow = (d ? ob + (size_t)(NTP + b * TS + t) * 1024 : ofs + (size_t)(b * TS + t) * 1024) + h * 64 + 4 * hi;
#pragma unroll
        for (int vt = 0; vt < 2; ++vt) { const float* srow = smid + ((size_t)chain * 64 + 32 * vt + r32) * 64 + 8 * hi;
            f32x16 D = (f32x16){};
#pragma unroll
            for (int ks = 0; ks < 4; ++ks) { const f32x4 a = *(const f32x4*)(srow + 16 * ks), c = *(const f32x4*)(srow + 16 * ks + 4);
                v4u w; w.x = pkh2(a.x, a.y); w.y = pkh2(a.z, a.w); w.z = pkh2(c.x, c.y); w.w = pkh2(c.z, c.w);
                D = __builtin_amdgcn_mfma_f32_32x32x16_f16(__builtin_bit_cast(h8, w), mf[ks], D, 0, 0, 0); }
#pragma unroll
            for (int g4 = 0; g4 < 4; ++g4) { bf16* o = orow + 32 * vt + 8 * g4; const v2u cur = *(const v2u*)o;
                v2u w; w.x = pk2(bflo(cur.x) + D[4 * g4], bfhi(cur.x) + D[4 * g4 + 1]); w.y = pk2(bflo(cur.y) + D[4 * g4 + 2], bfhi(cur.y) + D[4 * g4 + 3]); *(v2u*)o = w; } }
    }
}
__device__ __forceinline__ void post_scan_phase(const Params& p, int vcu, int G) {
    const int lane = threadIdx.x & 63, wid = threadIdx.x >> 6, gw = vcu * NWAVES + wid, NGW = G * NWAVES;
    const bf16* pav = (const bf16*)((unsigned char*)p.out + O_PAV); const bf16* ofp = (const bf16*)(p.ws + X_OFP); const bf16* ofs = (const bf16*)((unsigned char*)p.out + O_OFS);
    const bf16* ob = (const bf16*)((unsigned char*)p.out + O_OB); const float* bn = (const float*)(p.ws + WS_BN); bf16* yab = (bf16*)(p.ws + WS_YAB);
    struct Raw { v4u of, ob, vc, vp, vn, ga; float b0, b1; };
#define PS_LOAD(R, it_) do { const int itc_ = (it_) < NT * 2 ? (it_) : NT * 2 - 1; const int m_ = itc_ >> 1, c_ = (itc_ & 1) * 512 + 8 * lane; \
        const int T_ = (m_ < NTP) ? TP : TS, t_ = (m_ < NTP) ? (m_ & 255) : ((m_ - NTP) & 4095); \
        R.of = (m_ < NTP) ? *(const v4u*)(ofp + (size_t)m_ * 1024 + c_) : *(const v4u*)(ofs + (size_t)(m_ - NTP) * 1024 + c_); \
        R.ob = *(const v4u*)(ob + (size_t)m_ * 1024 + c_); R.vc = *(const v4u*)(pav + (size_t)m_ * 1024 + c_); \
        R.vp = *(const v4u*)(pav + (size_t)(t_ > 0 ? m_ - 1 : m_) * 1024 + c_); R.vn = *(const v4u*)(pav + (size_t)(t_ < T_ - 1 ? m_ + 1 : m_) * 1024 + c_); \
        R.ga = *(const v4u*)(yab + (size_t)m_ * 2048 + c_); R.b0 = bn[(size_t)m_ * 32 + (c_ >> 6) * 2]; R.b1 = bn[(size_t)m_ * 32 + (c_ >> 6) * 2 + 1]; } while (0)
    Raw ra, rb;
    if (gw < NT * 2) PS_LOAD(ra, gw);
    for (int it = gw; it < NT * 2; it += NGW) {
        PS_LOAD(rb, it + NGW);
        const int m = it >> 1, c0 = (it & 1) * 512 + 8 * lane;
        const int T = (m < NTP) ? TP : TS, t = (m < NTP) ? (m & 255) : ((m - NTP) & 4095);
        const bool okp = t > 0, okn = t < T - 1;
        float o[8], vmix[8], ga[8]; float sm = 0.f;
        const f32x4 mu0 = *(const f32x4*)(p.in[I_MU] + 2048 + c0), mu1 = *(const f32x4*)(p.in[I_MU] + 2048 + c0 + 4);
#pragma unroll
        for (int e = 0; e < 4; ++e) {
            o[2 * e] = bflo(ra.of[e]) + bflo(ra.ob[e]); o[2 * e + 1] = bfhi(ra.of[e]) + bfhi(ra.ob[e]); sm += o[2 * e] + o[2 * e + 1];
            const float c_l = bflo(ra.vc[e]), c_h = bfhi(ra.vc[e]);
            const float nb_l = (okp ? bflo(ra.vp[e]) : 0.f) + (okn ? bflo(ra.vn[e]) : 0.f), nb_h = (okp ? bfhi(ra.vp[e]) : 0.f) + (okn ? bfhi(ra.vn[e]) : 0.f);
            const float m_l = (e < 2) ? mu0[2 * e] : mu1[2 * e - 4], m_h = (e < 2) ? mu0[2 * e + 1] : mu1[2 * e - 3];
            vmix[2 * e] = c_l + m_l * (0.5f * nb_l - c_l); vmix[2 * e + 1] = c_h + m_h * (0.5f * nb_h - c_h);
            ga[2 * e] = bflo(ra.ga[e]); ga[2 * e + 1] = bfhi(ra.ga[e]); }
        const float mean = sum8(sm) * (1.f / 64.f);
        float q = 0.f;
#pragma unroll
        for (int e = 0; e < 8; ++e) { o[e] -= mean; q += o[e] * o[e]; }
        const float rs = rsqrtf(sum8(q) * (1.f / 64.f) + 64e-5f);
        const f32x4 lw0 = *(const f32x4*)(p.in[I_LNW] + c0), lw1 = *(const f32x4*)(p.in[I_LNW] + c0 + 4), lb0 = *(const f32x4*)(p.in[I_LNB] + c0), lb1 = *(const f32x4*)(p.in[I_LNB] + c0 + 4);
        const float bsum = ra.b0 + ra.b1;
        float y[8];
#pragma unroll
        for (int e = 0; e < 8; ++e) { const float lwv = (e < 4) ? lw0[e & 3] : lw1[e & 3], lbv = (e < 4) ? lb0[e & 3] : lb1[e & 3]; y[e] = (o[e] * rs * lwv + lbv + bsum * vmix[e]) * ga[e]; }
        v4u w; w.x = pk2(y[0], y[1]); w.y = pk2(y[2], y[3]); w.z = pk2(y[4], y[5]); w.w = pk2(y[6], y[7]);
        *(v4u*)(yab + (size_t)m * 2048 + c0) = w;
        ra = rb;
    }
#undef PS_LOAD
}
constexpr int AT_K = 0, AT_V = 49152, AT_SLOT = 16384, AT_X = 0;
#define AT_WAIT_BAR(N) asm volatile("s_waitcnt vmcnt(" #N ") lgkmcnt(0)\n\ts_barrier" ::: "memory")
__device__ __forceinline__ unsigned cvtpk(float lo, float hi) { typedef float f2_t __attribute__((ext_vector_type(2))); typedef __bf16 b2_t __attribute__((ext_vector_type(2))); f2_t v = {lo, hi}; b2_t b = __builtin_convertvector(v, b2_t); return __builtin_bit_cast(unsigned, b); }
__device__ __forceinline__ s16x4 vtr(const LAS unsigned char* p) { typedef short v4i16_t __attribute__((ext_vector_type(4))); return __builtin_bit_cast(s16x4, __builtin_amdgcn_ds_read_tr16_b64_v4i16((LAS v4i16_t*)p)); }
struct AttnCtx { const bf16 *q, *kp, *ks, *vp, *vs; bf16* yab; const float *kmax, *subln; float lam, kbase; };

__device__ __forceinline__ void attn_unit(const AttnCtx& A, LAS unsigned char* lds, int u) {
    const int tid = threadIdx.x, lane = tid & 63, r32 = lane & 31, hi = lane >> 5; const int wid = __builtin_amdgcn_readfirstlane(tid >> 6);
    const int qg = wid >> 1, comp = wid & 1;
    const bool smp = u < 1024; int b, h, qb;
    if (smp) { const int combo = u >> 5; b = combo >> 3; h = combo & 7; qb = u & 31; } else { const int pu = u - 1024; b = pu >> 4; h = (pu >> 1) & 7; qb = pu & 1; }
    const int tokq0 = (smp ? NTP + b * TS : b * TP) + qb * 128;
    const bf16* Km = smp ? A.ks + (size_t)b * TKS * 1024 : A.kp + (size_t)b * TP * 1024;
    const bf16* Vm = smp ? A.vs + (size_t)b * TKS * 1024 : A.vp + (size_t)b * TP * 1024;
    const int nkt = smp ? (TKS / 64) : (TP / 64);
    const bf16* ksrc0 = Km + (size_t)lane * 1024 + h * 128 + wid * 8;
    const bf16* vsrc0 = Vm + (size_t)(16 * (wid & 3) + (lane >> 2)) * 1024 + h * 128 + (wid >> 2) * 32 + (lane & 3) * 8;
    const unsigned lds0 = (unsigned)(uintptr_t)lds;
#define AT_DMA(t, slot) do { const size_t go_ = (size_t)(t) * 64 * 1024; \
        glds16(ksrc0 + go_,      (unsigned)__builtin_amdgcn_readfirstlane(lds0 + AT_K + (slot) * AT_SLOT + wid * 1024)); \
        glds16(ksrc0 + go_ + 64, (unsigned)__builtin_amdgcn_readfirstlane(lds0 + AT_K + (slot) * AT_SLOT + (wid + 8) * 1024)); \
        glds16(vsrc0 + go_,      (unsigned)__builtin_amdgcn_readfirstlane(lds0 + AT_V + (slot) * AT_SLOT + wid * 1024)); \
        glds16(vsrc0 + go_ + 64, (unsigned)__builtin_amdgcn_readfirstlane(lds0 + AT_V + (slot) * AT_SLOT + (wid + 8) * 1024)); } while (0)
    AT_DMA(0, 0);
    bf16x8 qf[4];
    const bf16* qrow = A.q + (size_t)(tokq0 + qg * 32 + r32) * 1024 + h * 128 + comp * 64 + hi * 8;
#pragma unroll
    for (int d0 = 0; d0 < 4; ++d0) qf[d0] = *(const bf16x8*)(qrow + d0 * 16);
    float mq;
    { float ss0 = 0.f;
#pragma unroll
      for (int d0 = 0; d0 < 4; ++d0)
#pragma unroll
          for (int e = 0; e < 8; ++e) { const float x0 = bf2f((unsigned short)qf[d0][e]); ss0 += x0 * x0; }
      ss0 += __shfl_xor(ss0, 32);
      float kb0 = A.kbase;
      if (smp) kb0 = fmaxf(kb0, sqrtf(A.kmax[(b * 8 + h) * 2 + comp]) * 1.01f);
      mq = sqrtf(ss0) * kb0; }
    f32x16 negm;
#pragma unroll
    for (int r = 0; r < 16; ++r) negm[r] = -mq;
    f32x16 O[4];
#pragma unroll
    for (int i = 0; i < 4; ++i) O[i] = (f32x16){};
    float l = 0.f;
    const int vbase = ((lane >> 4) & 1) * 32 + (lane & 3) * 8 + (4 * hi + ((lane & 15) >> 2)) * 64;
    int slot = 0;
    for (int t = 0; t < nkt; ++t) {
        const int nslot = (slot == 2) ? 0 : slot + 1;
        if (t + 1 < nkt) { AT_DMA(t + 1, nslot); AT_WAIT_BAR(4); } else { AT_WAIT_BAR(0); }
        const LAS unsigned char* Ks = lds + AT_K + slot * AT_SLOT + (comp * 8 + hi) * 1024 + r32 * 16;
        const LAS unsigned char* Vs = lds + AT_V + slot * AT_SLOT + vbase;
        bf16x8 pw[4];
#pragma unroll
        for (int kh = 0; kh < 2; ++kh) {
            f32x16 s; bf16x8 kf[4];
#pragma unroll
            for (int d0 = 0; d0 < 4; ++d0) kf[d0] = *(const LAS bf16x8*)(Ks + d0 * 2048 + kh * 512);
            s = __builtin_amdgcn_mfma_f32_32x32x16_bf16(kf[0], qf[0], negm, 0, 0, 0);
#pragma unroll
            for (int d0 = 1; d0 < 4; ++d0) s = __builtin_amdgcn_mfma_f32_32x32x16_bf16(kf[d0], qf[d0], s, 0, 0, 0);
            float ls = 0.f;
#pragma unroll
            for (int r = 0; r < 16; ++r) { s[r] = __builtin_amdgcn_exp2f(s[r]); ls += s[r]; }
            l += ls;
#pragma unroll
            for (int sx = 0; sx < 2; ++sx) { v4u w; w.x = cvtpk(s[8 * sx + 0], s[8 * sx + 1]); w.y = cvtpk(s[8 * sx + 2], s[8 * sx + 3]); w.z = cvtpk(s[8 * sx + 4], s[8 * sx + 5]); w.w = cvtpk(s[8 * sx + 6], s[8 * sx + 7]);
                pw[2 * kh + sx] = __builtin_bit_cast(bf16x8, w); }
        }
#pragma unroll
        for (int dvb = 0; dvb < 4; ++dvb) { bf16x8 vf[4];
#pragma unroll
            for (int ks = 0; ks < 4; ++ks) { const s16x4 lo = vtr(Vs + dvb * 4096 + ks * 1024), hh = vtr(Vs + dvb * 4096 + ks * 1024 + 512);
                vf[ks] = (bf16x8){lo[0], lo[1], lo[2], lo[3], hh[0], hh[1], hh[2], hh[3]}; }
#pragma unroll
            for (int ks = 0; ks < 4; ++ks) O[dvb] = __builtin_amdgcn_mfma_f32_32x32x16_bf16(vf[ks], pw[ks], O[dvb], 0, 0, 0);
        }
        slot = nslot;
    }
    l += __shfl_xor(l, 32);
    const float il = (comp ? A.lam : 1.f) / l;
    AT_WAIT_BAR(0);
    LAS float* xb = (LAS float*)(lds + AT_X + qg * 16384) + lane;
    if (comp == 1) {
#pragma unroll
        for (int dvb = 0; dvb < 4; ++dvb)
#pragma unroll
            for (int r = 0; r < 16; ++r) xb[(dvb * 16 + r) * 64] = O[dvb][r] * il;
    }
    AT_WAIT_BAR(0);
    if (comp == 0) {
        float ss = 0.f;
#pragma unroll
        for (int dvb = 0; dvb < 4; ++dvb)
#pragma unroll
            for (int r = 0; r < 16; ++r) { const float o = O[dvb][r] * il - xb[(dvb * 16 + r) * 64]; O[dvb][r] = o; ss += o * o; }
        ss += __shfl_xor(ss, 32);
        const float rinv = rsqrtf(ss * (1.f / 128.f) + 1e-6f) * 0.8f;
        bf16* yrow = A.yab + (size_t)(tokq0 + qg * 32 + r32) * 2048 + 1024 + h * 128 + 4 * hi;
#pragma unroll
        for (int dvb = 0; dvb < 4; ++dvb)
#pragma unroll
            for (int gq = 0; gq < 4; ++gq) { const int dv0 = 32 * dvb + 8 * gq;
                const v2u gb = *(const v2u*)(yrow + dv0); const f32x4 sw = *(const f32x4*)(A.subln + dv0 + 4 * hi);
                const float y0 = O[dvb][4 * gq + 0] * rinv * sw[0] * bflo(gb.x), y1 = O[dvb][4 * gq + 1] * rinv * sw[1] * bfhi(gb.x),
                            y2 = O[dvb][4 * gq + 2] * rinv * sw[2] * bflo(gb.y), y3 = O[dvb][4 * gq + 3] * rinv * sw[3] * bfhi(gb.y);
                v2u w; w.x = pk2(y0, y1); w.y = pk2(y2, y3); *(v2u*)(yrow + dv0) = w; }
    }
    AT_WAIT_BAR(0);
#undef AT_DMA
}
__device__ __forceinline__ void attn_phase(const Params& p, LAS unsigned char* lds, int vcu, int G) {
    AttnCtx A; A.q = (const bf16*)(p.ws + X_Q); A.kp = (const bf16*)(p.ws + X_KP); A.ks = (const bf16*)(p.ws + X_KS);
    A.vp = (const bf16*)((unsigned char*)p.out + O_VP); A.vs = (const bf16*)((unsigned char*)p.out + O_VS); A.yab = (bf16*)(p.ws + WS_YAB);
    A.kmax = (const float*)(p.ws + WS_KMAX); A.subln = p.in[I_SUBLN];
    const int lane = threadIdx.x & 63;
    { const float* lv = p.in[I_LAM]; const float s01 = wave_sum(lv[lane] * lv[64 + lane]), s23 = wave_sum(lv[128 + lane] * lv[192 + lane]);
      A.lam = __expf(s01) - __expf(s23) + 0.2f;
      A.kbase = 8.f * wave_max(fabsf(p.in[I_KN][lane])) * 1.01f; }
    for (int u = vcu; u < 1280; u += G) attn_unit(A, lds, u);
}
__device__ __forceinline__ void ctx_convert(const Params& p, int vcu, int G) {
    bf16* ks = (bf16*)(p.ws + X_KS); bf16* vs = (bf16*)((unsigned char*)p.out + O_VS);
    const int n = 2 * 4 * 256 * 256;
    for (int i = vcu * NTHR + threadIdx.x; i < n; i += G * NTHR) {
        const int tsr = i >> 18, rem = i & 262143, b = rem >> 16, t = (rem >> 8) & 255, c4 = rem & 255;
        const f32x4 v = *(const f32x4*)((tsr ? p.in[I_CV] : p.in[I_CK]) + ((size_t)(b * 256 + t) * 1024 + c4 * 4));
        v2u w; w.x = pk2(v.x, v.y); w.y = pk2(v.z, v.w);
        *(v2u*)((tsr ? vs : ks) + ((size_t)b * TKS + 4096 + t) * 1024 + c4 * 4) = w;
    }
}
__device__ __forceinline__ void conv_phase(const Params& p, int vcu, int G) {
    const int lane = threadIdx.x & 63, wid = threadIdx.x >> 6, gw = vcu * NWAVES + wid, NGW = G * NWAVES;
    bf16* pg = (bf16*)(p.ws + WS_PG); const float* cw = p.in[I_CONVW]; const float* cb = p.in[I_CONVB];
    for (int it = gw; it < NT * 4; it += NGW) {
        const int m = it >> 2, c0 = (it & 3) * 512 + 8 * lane;
        const int T = (m < NTP) ? TP : TS, t = (m < NTP) ? (m & 255) : ((m - NTP) & 4095);
        const v4u pc = *(const v4u*)(pg + (size_t)m * 4096 + c0), gt = *(const v4u*)(pg + (size_t)m * 4096 + 2048 + c0);
        v4u pp = {0u, 0u, 0u, 0u}, pn = {0u, 0u, 0u, 0u};
        if (t > 0) pp = *(const v4u*)(pg + (size_t)(m - 1) * 4096 + c0);
        if (t < T - 1) pn = *(const v4u*)(pg + (size_t)(m + 1) * 4096 + c0);
        v4u o;
#pragma unroll
        for (int e = 0; e < 4; ++e) { const int c = c0 + 2 * e;
            const float y0 = bflo(gt[e]) * (cw[c] * bflo(pp[e]) + cw[2048 + c] * bflo(pc[e]) + cw[4096 + c] * bflo(pn[e]) + cb[c]);
            const float y1 = bfhi(gt[e]) * (cw[c + 1] * bfhi(pp[e]) + cw[2048 + c + 1] * bfhi(pc[e]) + cw[4096 + c + 1] * bfhi(pn[e]) + cb[c + 1]);
            o[e] = pk2(y0, y1); }
        *(v4u*)(pg + (size_t)m * 4096 + 2048 + c0) = o;
    }
}
constexpr int N_PHASES = 13;
__global__ void __launch_bounds__(NTHR, 2) hybrid_fwd(Params p) {
    extern __shared__ __attribute__((aligned(16))) unsigned char lds_raw[];
    LAS unsigned char* lds = (LAS unsigned char*)lds_raw;
    const int tid = threadIdx.x, G = gridDim.x, bx = blockIdx.x;
    const int vcu = (G % 8 == 0) ? (bx % 8) * (G / 8) + bx / 8 : bx;
    volatile LAS unsigned* misc = (volatile LAS unsigned*)(lds + LDS_MISC);
    if (tid < 64) misc[tid] = 0u;
    __syncthreads();
    XcdBarrier bar = xcd_barrier_post((unsigned*)(p.ws + WS_CTL) + 1024, misc + 8);
    const int lo = p.ph_lo, hi = p.ph_hi;
#ifdef ONLY_PHASE
#define IN(k) ((k) == ONLY_PHASE && lo <= (k) && (k) < hi)
#else
#define IN(k) (lo <= (k) && (k) < hi)
#endif
#define SEAM(k) do { if (IN(k) && IN((k) + 1)) xcd_barrier(bar); } while (0)
    unsigned char* ws = p.ws; unsigned char* ob = (unsigned char*)p.out;
    const float* ada = (const float*)(ws + WS_ADA);

    if (IN(0)) { p0_prologue(p, lds, vcu, G); } SEAM(0);
    if (IN(1)) { weight_copies(p, lds, vcu, G); h_phase(p, 0, vcu, G); } SEAM(1);
    if (IN(2)) {
        pg8::Gemm g{(const bf16*)(ws + WS_H), (const bf16*)(ws + WS_WIN), NT, 4352, 1024, 1024}; pg8::StaticOrder S; S.init(NT, 4352, 1024, G, bx);
        Epi1a E{ws, ob};
        pg8::gemm_phase<Epi1a, pg8::StaticOrder, true, true>(lds, g, S, E);
    } SEAM(2);
    if (IN(3)) { scan_phase(p, lds, vcu, G); } SEAM(3);
    if (IN(4)) { scan_fixup_phase(p, vcu, G); } SEAM(4);
    if (IN(5)) { post_scan_phase(p, vcu, G); } SEAM(5);
    if (IN(6)) {
        pg8::Gemm g{(const bf16*)(ws + WS_H), (const bf16*)(ws + WS_WIN) + (size_t)4352 * 1024, NT, 4096, 1024, 1024}; pg8::StaticOrder S; S.init(NT, 4096, 1024, G, bx);
        LAS float* tab = (LAS float*)(lds + 131072);
        for (int i = tid; i < 2048 + 128; i += NTHR) tab[i] = (i < 2048) ? ((const float*)(ws + WS_ROPE))[i] : (i < 2112 ? p.in[I_QN][i - 2048] : p.in[I_KN][i - 2112]);
        __syncthreads();
        Epi1b E{(bf16*)(ws + X_Q), (bf16*)(ws + X_KP), (bf16*)(ob + O_VP), (bf16*)(ws + WS_YAB), (float*)(ob + O_NK), (float*)(ob + O_NV), tab};
        pg8::gemm_phase<Epi1b, pg8::StaticOrder, true, true>(lds, g, S, E);
        ctx_convert(p, vcu, G);
    } SEAM(6);
    if (IN(7)) { attn_phase(p, lds, vcu, G); } SEAM(7);
    if (IN(8)) {
        pg8::Gemm g{(const bf16*)(ws + WS_YAB), (const bf16*)(ws + WS_WOUT0), NT, 1024, 2048, 2048}; pg8::TailSplitOrder S; S.init(NT, 1024, 2048, G, bx);
        EpiResT<true> E{p.in[I_XP], p.in[I_XS] - (size_t)NTP * 1024, nullptr, (bf16*)(ws + WS_X1B), ada,
            (float*)(ws + WS_X), (unsigned*)(ws + WS_CTL) + CW_SPLIT};
        pg8::gemm_phase<EpiResT<true>, pg8::TailSplitOrder, true, true>(lds, g, S, E);
        if (S.split) { LAS float* scr = (LAS float*)(lds + 32768); __syncthreads(); conv_tiles<2>(p.in[I_OWIN], 1024, 8192, (bf16*)(ws + WS_WIN), vcu, 128 * 16, G, scr); }
        else { const int nsec = 320 - G; if (nsec >= 0 && nsec < G && bx >= nsec) { LAS float* scr = (LAS float*)(lds + 32768); __syncthreads();
            conv_tiles<2>(p.in[I_OWIN], 1024, 8192, (bf16*)(ws + WS_WIN), bx - nsec, 128 * 16, G - nsec, scr); }
          else if (!(nsec >= 0 && nsec < G)) { LAS float* scr = (LAS float*)(lds + 32768); __syncthreads(); conv_tiles<2>(p.in[I_OWIN], 1024, 8192, (bf16*)(ws + WS_WIN), vcu, 128 * 16, G, scr); } }
    } SEAM(8);
    if (IN(9)) {
        h_phase(p, 1, vcu, G);
    } SEAM(9);
    if (IN(10)) {
        pg8::Gemm g{(const bf16*)(ws + WS_H), (const bf16*)(ws + WS_WIN), NT, 8192, 1024, 1024}; pg8::StaticOrder S; S.init(NT, 8192, 1024, G, bx);
        EpiGateConv E{(bf16*)(ws + WS_YAB), (float*)(ws + WS_CSB), p.in[I_CONVW], p.in[I_CONVB], (LAS float*)(lds + 131072)};
        pg8::gemm_phase<EpiGateConv, pg8::StaticOrder, true, true>(lds, g, S, E);
    } SEAM(10);
    if (IN(11)) { conv_fix_phase(p, vcu, G); } SEAM(11);
    if (IN(12)) {
        pg8::Gemm g{(const bf16*)(ws + WS_YAB), (const bf16*)(ws + WS_WOUT1), NT, 1024, 2048, 2048}; pg8::TailSplitOrder S; S.init(NT, 1024, 2048, G, bx);
        EpiResT<false> E{nullptr, nullptr, p.out, (bf16*)(ws + WS_X1B), ada + 5 * 3072, (float*)(ws + WS_WIN), (unsigned*)(ws + WS_CTL) + CW_SPLIT + 2048};
        pg8::gemm_phase<EpiResT<false>, pg8::TailSplitOrder, true, true>(lds, g, S, E);
    }
#undef IN
#undef SEAM
}

#ifndef MK_N_LAUNCHES
#define MK_N_LAUNCHES 1
#endif
extern "C" void kernel_launch(void* const* d_in, const int* in_sizes, int n_in, void* d_out, int out_size, void* d_ws, size_t ws_size, hipStream_t stream) {
    static int grid = 0;
    if (grid == 0) {
        int dev = 0, cus = 0;
        if (n_in != 31 || ws_size < 256 * MiB || hipGetDevice(&dev) != hipSuccess || hipDeviceGetAttribute(&cus, hipDeviceAttributeMultiprocessorCount, dev) != hipSuccess) { fprintf(stderr, "kernel_launch: unexpected arguments / device (n_in %d, ws %zu)\n", n_in, ws_size); grid = -1; return; }
        if (hipFuncSetAttribute((const void*)hybrid_fwd, hipFuncAttributeMaxDynamicSharedMemorySize, LDS_BYTES) != hipSuccess) { fprintf(stderr, "kernel_launch: hipFuncSetAttribute failed\n"); grid = -1; return; }
        int per_cu = 0;
        if (hipOccupancyMaxActiveBlocksPerMultiprocessor(&per_cu, (const void*)hybrid_fwd, NTHR, LDS_BYTES) != hipSuccess || per_cu < 1) fprintf(stderr, "kernel_launch: occupancy query reports %d blocks per CU\n", per_cu);
        (void)hipGetLastError();
        grid = cus;
    }
    if (grid < 0) return;
    Params p{};
    for (int i = 0; i < 31; ++i) p.in[i] = (const float*)d_in[i];
    p.out = (float*)d_out; p.ws = (unsigned char*)d_ws;
    (void)hipMemsetAsync((char*)d_ws + WS_CTL, 0, CTL_ZERO_BYTES, stream);
    if (MK_N_LAUNCHES == 1) {
        p.ph_lo = 0; p.ph_hi = N_PHASES;
        hipLaunchKernelGGL(hybrid_fwd, dim3(grid), dim3(NTHR), LDS_BYTES, stream, p);
    } else {
        for (int k = 0; k < N_PHASES; ++k) { p.ph_lo = k; p.ph_hi = k + 1;
            hipLaunchKernelGGL(hybrid_fwd, dim3(grid), dim3(NTHR), LDS_BYTES, stream, p);
        }
    }
    const hipError_t le = hipPeekAtLastError();
    if (le != hipSuccess) fprintf(stderr, "kernel_launch: launch failed: %s\n", hipGetErrorName(le));
}
```
